# Optimizing an MI355X kernel written in HIP

```python
import jax, jax.numpy as jnp
from jax import lax
import numpy as np

D_MODEL = 1024
BATCH = 16
SEQ = 256
DEPTH = 1
DEC_BATCH = 4
DEC_SEQ = 1024
PAST_LEN = 512

GRID_W = 64
CHUNK = 128
N_HEADS = 8
QK_NOPE = 64
QK_ROPE = 32
V_DIM = 64
Q_RANK = 384
KV_RANK = 256
ATTN_W = N_HEADS * V_DIM
GMLP_W = D_MODEL - ATTN_W
GMLP_GROUPS = 4
GMLP_DG = GMLP_W // GMLP_GROUPS
D_FF = 2816
CONV_W = 3
ROPE_THETA = 10000.0
EPS = 1e-6
Q_BLOCK = 128
IN_W = Q_RANK + KV_RANK + QK_ROPE + 2 * GMLP_W
SPLITS = [Q_RANK, Q_RANK + KV_RANK, Q_RANK + KV_RANK + QK_ROPE, Q_RANK + KV_RANK + QK_ROPE + GMLP_W]

kernel_name = "hymba_mla_gmlp_convffn_dit_step"


def rmsnorm(x, g):
    xf = x.astype(jnp.float32)
    y = xf * lax.rsqrt(jnp.mean(xf * xf, axis=-1, keepdims=True) + EPS)
    return (y * g.astype(jnp.float32)).astype(x.dtype)


def group_rmsnorm(x, g):
    shape = x.shape
    xf = x.astype(jnp.float32).reshape(shape[:-1] + (GMLP_GROUPS, GMLP_DG))
    y = xf * lax.rsqrt(jnp.mean(xf * xf, axis=-1, keepdims=True) + EPS)
    return (y.reshape(shape) * g.astype(jnp.float32)).astype(x.dtype)


def rope_angles(length):
    rows = length // GRID_W
    pos = jnp.arange(rows * GRID_W)
    row = (pos // GRID_W).astype(jnp.float32)
    col = (pos % GRID_W).astype(jnp.float32)
    n_freq = QK_ROPE // 4
    inv = ROPE_THETA ** (-(jnp.arange(n_freq, dtype=jnp.float32) / n_freq))
    return row[:, None] * inv, col[:, None] * inv


def rotate(x, ang):
    half = x.shape[-1] // 2
    x1, x2 = x[..., :half], x[..., half:]
    cs, sn = jnp.cos(ang).astype(x.dtype), jnp.sin(ang).astype(x.dtype)
    return jnp.concatenate([x1 * cs - x2 * sn, x2 * cs + x1 * sn], axis=-1)


def rope_2d(x, ang_r, ang_c):
    half = QK_ROPE // 2
    return jnp.concatenate([rotate(x[..., :half], ang_r), rotate(x[..., half:], ang_c)], axis=-1)


def adaln_mod(cond, ada_w, ada_b):
    m = jax.nn.silu(cond) @ ada_w + ada_b
    return jnp.split(m, 6, axis=-1)


def mla_expand(ckv, w_ukv):
    B, L, _ = ckv.shape
    kv = (ckv @ w_ukv).reshape(B, L, N_HEADS, QK_NOPE + V_DIM)
    return kv[..., :QK_NOPE], kv[..., QK_NOPE:]


def mla_attention(q_nope, q_rope, k_nope, k_rope, v):
    B, L, H, _ = q_nope.shape
    nb = L // Q_BLOCK
    scale = (QK_NOPE + QK_ROPE) ** -0.5
    qn = q_nope.reshape(B, nb, Q_BLOCK, H, QK_NOPE).swapaxes(0, 1)
    qr = q_rope.reshape(B, nb, Q_BLOCK, H, QK_ROPE).swapaxes(0, 1)

    def block(args):
        qn_b, qr_b = args
        s = jnp.einsum("bqhd,bkhd->bhqk", qn_b, k_nope) + jnp.einsum("bqhr,bkr->bhqk", qr_b, k_rope)
        pr = jax.nn.softmax(s.astype(jnp.float32) * scale, axis=-1).astype(v.dtype)
        return jnp.einsum("bhqk,bkhd->bqhd", pr, v)

    o = lax.map(block, (qn, qr))
    return o.swapaxes(0, 1).reshape(B, L, H * V_DIM)


def spatial_gating(u, v, v_norm_g, w_s, b_s):
    B, L, _ = u.shape
    u = jax.nn.gelu(u, approximate=False)
    v = group_rmsnorm(jax.nn.gelu(v, approximate=False), v_norm_g)
    vc = v.reshape(B, L // CHUNK, CHUNK, GMLP_GROUPS, GMLP_DG)
    s = jnp.einsum("gij,bnjgc->bnigc", w_s, vc) + b_s.T[None, None, :, :, None]
    return u * s.reshape(B, L, GMLP_W)


def conv_ffn(h, w_up, conv_w, conv_b, w_down):
    L = h.shape[1]
    a = h @ w_up
    pad = CONV_W // 2
    ap = jnp.pad(a, ((0, 0), (pad, pad), (0, 0)))
    acc = conv_b
    for k in range(CONV_W):
        acc = acc + ap[:, k:k + L] * conv_w[k]
    gate, val = jnp.split(acc, 2, axis=-1)
    return (jax.nn.silu(gate) * val) @ w_down


def trunk_layer(x, mods, p, ctx=None, ang=None):
    shift1, scale1, gate1, shift2, scale2, gate2 = mods
    B, L, _ = x.shape
    h = rmsnorm(x, p["norm1_g"]) * (1 + scale1) + shift1
    q_lat, kv_lat, k_rope, u, v = jnp.split(h @ p["w_in"], SPLITS, axis=-1)
    q = (rmsnorm(q_lat, p["q_norm_g"]) @ p["w_uq"]).reshape(B, L, N_HEADS, QK_NOPE + QK_ROPE)
    q_nope, q_rope = q[..., :QK_NOPE], q[..., QK_NOPE:]
    ckv = rmsnorm(kv_lat, p["kv_norm_g"])
    k_nope, val = mla_expand(ckv, p["w_ukv"])
    k_rope_own = k_rope
    if ctx is not None:
        ang_r, ang_c = ang
        q_rope = rope_2d(q_rope, ang_r[:, None, :], ang_c[:, None, :])
        k_rope_lat = rope_2d(k_rope, ang_r, ang_c)
        ckv_ctx, krope_ctx = ctx
        kn_ctx, v_ctx = mla_expand(ckv_ctx, p["w_ukv"])
        k_nope = jnp.concatenate([kn_ctx, k_nope], axis=1)
        val = jnp.concatenate([v_ctx, val], axis=1)
        k_rope = jnp.concatenate([krope_ctx, k_rope_lat], axis=1)
    attn = mla_attention(q_nope, q_rope, k_nope, k_rope, val)
    g_out = spatial_gating(u, v, p["v_norm_g"], p["w_s"], p["b_s"])
    mix = jnp.concatenate([rmsnorm(attn, p["out_g_attn"]), rmsnorm(g_out, p["out_g_gmlp"])], axis=-1)
    x = x + gate1 * (mix @ p["w_o"])
    h2 = rmsnorm(x, p["norm2_g"]) * (1 + scale2) + shift2
    x = x + gate2 * conv_ffn(h2, p["w_up"], p["conv_w"], p["conv_b"], p["w_down"])
    return x, ckv, k_rope_own


def setup_inputs(seed: int = 0) -> dict:
    key = jax.random.key(seed)
    ks = jax.random.split(key, 32)

    def nrm(k, shape, scale=1.0):
        return jax.random.normal(k, shape, jnp.float32) * scale

    def gain(k, shape):
        return 1.0 + 0.02 * jax.random.normal(k, shape, jnp.float32)

    L = DEPTH
    return {
        "x_prompt": nrm(ks[0], (BATCH, SEQ, D_MODEL)),
        "x_sample": nrm(ks[1], (DEC_BATCH, DEC_SEQ, D_MODEL)),
        "cache_ckv": nrm(ks[2], (DEC_BATCH, DEPTH, PAST_LEN, KV_RANK)),
        "cache_krope": nrm(ks[3], (DEC_BATCH, DEPTH, PAST_LEN, QK_ROPE)),
        "c": nrm(ks[4], (DEC_BATCH, D_MODEL)),
        "c_ctx": nrm(ks[5], (D_MODEL,)),
        "ada_w": nrm(ks[6], (L, D_MODEL, 6 * D_MODEL), 0.5 * D_MODEL ** -0.5),
        "ada_b": nrm(ks[7], (L, 6 * D_MODEL), 0.02),
        "norm1_g": gain(ks[8], (L, D_MODEL)),
        "w_in": nrm(ks[9], (L, D_MODEL, IN_W), D_MODEL ** -0.5),
        "q_norm_g": gain(ks[10], (L, Q_RANK)),
        "w_uq": nrm(ks[11], (L, Q_RANK, N_HEADS * (QK_NOPE + QK_ROPE)), Q_RANK ** -0.5),
        "kv_norm_g": gain(ks[12], (L, KV_RANK)),
        "w_ukv": nrm(ks[13], (L, KV_RANK, N_HEADS * (QK_NOPE + V_DIM)), KV_RANK ** -0.5),
        "v_norm_g": gain(ks[14], (L, GMLP_W)),
        "w_s": nrm(ks[15], (L, GMLP_GROUPS, CHUNK, CHUNK), CHUNK ** -0.5),
        "b_s": gain(ks[16], (L, GMLP_GROUPS, CHUNK)),
        "out_g_attn": gain(ks[17], (L, ATTN_W)),
        "out_g_gmlp": gain(ks[18], (L, GMLP_W)),
        "w_o": nrm(ks[19], (L, D_MODEL, D_MODEL), D_MODEL ** -0.5),
        "norm2_g": gain(ks[20], (L, D_MODEL)),
        "w_up": nrm(ks[21], (L, D_MODEL, 2 * D_FF), D_MODEL ** -0.5),
        "conv_w": nrm(ks[22], (L, CONV_W, 2 * D_FF), CONV_W ** -0.5),
        "conv_b": nrm(ks[23], (L, 2 * D_FF), 0.02),
        "w_down": nrm(ks[24], (L, D_FF, D_MODEL), D_FF ** -0.5),
        "final_g": gain(ks[25], (D_MODEL,)),
    }


def reference(x_prompt, x_sample, cache_ckv, cache_krope, c, c_ctx, ada_w, ada_b, norm1_g, w_in,
              q_norm_g, w_uq, kv_norm_g, w_ukv, v_norm_g, w_s, b_s, out_g_attn, out_g_gmlp, w_o,
              norm2_g, w_up, conv_w, conv_b, w_down, final_g):
    ang = rope_angles(x_sample.shape[1])
    xp, xs = x_prompt, x_sample
    ckv_list, krope_list = [], []
    for l in range(DEPTH):
        p = {
            "norm1_g": norm1_g[l], "w_in": w_in[l], "q_norm_g": q_norm_g[l], "w_uq": w_uq[l],
            "kv_norm_g": kv_norm_g[l], "w_ukv": w_ukv[l], "v_norm_g": v_norm_g[l], "w_s": w_s[l],
            "b_s": b_s[l], "out_g_attn": out_g_attn[l], "out_g_gmlp": out_g_gmlp[l], "w_o": w_o[l],
            "norm2_g": norm2_g[l], "w_up": w_up[l], "conv_w": conv_w[l], "conv_b": conv_b[l],
            "w_down": w_down[l],
        }
        mods_ctx = adaln_mod(c_ctx, ada_w[l], ada_b[l])
        mods_lat = adaln_mod(c[:, None, :], ada_w[l], ada_b[l])
        xp, ckv_l, krope_l = trunk_layer(xp, mods_ctx, p)
        ckv_list.append(ckv_l)
        krope_list.append(krope_l)
        xs, _, _ = trunk_layer(xs, mods_lat, p, ctx=(cache_ckv[:, l], cache_krope[:, l]), ang=ang)
    new_ckv = jnp.stack(ckv_list, axis=1)
    new_krope = jnp.stack(krope_list, axis=1)
    y_prompt = rmsnorm(xp, final_g)
    y_sample = rmsnorm(xs, final_g)
    return (y_prompt, y_sample, new_ckv, new_krope)
```

```cpp
#include <hip/hip_runtime.h>
#include <hip/hip_cooperative_groups.h>
#include <cstdio>
#include <cstdint>
namespace cg = cooperative_groups;
namespace pg8 {
#define PG8_LAS __attribute__((address_space(3)))
typedef unsigned short bf16_t;
typedef short bf16x8 __attribute__((ext_vector_type(8)));
typedef float f32x4 __attribute__((ext_vector_type(4)));
typedef unsigned u32x4 __attribute__((ext_vector_type(4)));
constexpr int BM = 256, BK = 64, HALF = 128, HTB = HALF * BK * 2  , STAGE_BYTES = 8 * HTB, NXCD = 8, WGM = 8;

__host__ __device__ __forceinline__ int lds_byte(int r, int c) { const int st = (r >> 4) * 2 + (c >> 5), rr = r & 15, cc = c & 31, ob = rr * 64 + cc * 2; return st * 1024 + (ob ^ (((ob >> 9) & 1) << 5)); }
__host__ __device__ __forceinline__ void stage_rc(int b, int& R, int& C) { const int st = b / 1024, sb = b % 1024, swz = sb ^ (((sb >> 9) & 1) << 5); R = (st >> 1) * 16 + swz / 64; C = (st & 1) * 32 + (swz % 64) / 2; }
__host__ __device__ __forceinline__ int perm32(int rho) { const int n = rho >> 4, i = rho & 15; return 8 * (i >> 2) + 4 * n + (i & 3); }

struct Unit { int pm, pn; };
struct Gemm { const bf16_t* A; const bf16_t* Bt; int M, N, K; };

struct StaticOrder {
    int nM, nN, nwg, G, c;
    __host__ __device__ void init(int M, int N, int G_, int c_) { nM = M / BM; nN = N / BM; nwg = nM * nN; G = G_; c = c_; }
    __host__ __device__ bool next(int i, Unit& u) const {
        const long L = (long)i * G + c; if (L >= nwg) return false;
        int wgid = (int)L; { const int q = nwg / NXCD, r = nwg % NXCD, xcd = wgid % NXCD, off = wgid / NXCD; wgid = (xcd < r ? xcd * (q + 1) : r * (q + 1) + (xcd - r) * q) + off; }
        const int nig = WGM * nN, gid = wgid / nig, fm = gid * WGM, gsz = (nM - fm) < WGM ? (nM - fm) : WGM;
        u.pm = fm + ((wgid % nig) % gsz); u.pn = (wgid % nig) / gsz; return true;
    }
    __device__ __forceinline__ void a_ready(const Unit&) const {}
    __device__ __forceinline__ void done(const Unit&) const {}
};

__device__ __forceinline__ unsigned cvt_pk_bf16(float lo, float hi) { unsigned r; asm volatile("v_cvt_pk_bf16_f32 %0, %1, %2" : "=v"(r) : "v"(lo), "v"(hi)); return r; }
typedef float f32x2 __attribute__((ext_vector_type(2)));
__device__ __forceinline__ f32x2 gelu_pk(f32x2 v) {
    const f32x2 av = __builtin_elementwise_abs(v), d = av * 0.2316418882f + 1.0f;
    f32x2 t; t.x = __builtin_amdgcn_rcpf(d.x); t.y = __builtin_amdgcn_rcpf(d.y);
    f32x2 q = t * 0.5307027145f + (-0.7265760135f); q = q * t + 0.7107068705f; q = q * t + (-0.142248368f); q = q * t + 0.127414796f; q = q * t;
    const f32x2 s = (v * v) * (-0.72134752044f);
    f32x2 e; e.x = __builtin_amdgcn_exp2f(s.x); e.y = __builtin_amdgcn_exp2f(s.y);
    const f32x2 m = v * (q * e), r = v - m;
    f32x2 o; o.x = v.x < 0.f ? m.x : r.x; o.y = v.y < 0.f ? m.y : r.y; return o;
}
template <class Epi, class Sched, bool ALIGN_EPI = false, bool SP2 = false>
__device__ __forceinline__ void gemm_phase(PG8_LAS unsigned char* lds, const Gemm g, const Sched& S, const Epi& E) {
    const int tid = threadIdx.x, wid = __builtin_amdgcn_readfirstlane(tid >> 6), lane = tid & 63, wr = wid >> 2, wc = wid & 3, fr = lane & 15, fq = lane >> 4;
    const int K = g.K, nt = K / BK;
    unsigned voffA[2], voffB[2];
#pragma unroll
    for (int i = 0; i < 2; ++i) { int R, C; stage_rc(tid * 16 + i * 8192, R, C); const int Rb = Epi::PERM ? ((R & ~31) + perm32(R & 31)) : R;
        voffA[i] = (unsigned)(R * K + C) * 2u; voffB[i] = (unsigned)(Rb * K + C) * 2u; }
    const size_t kstep = (size_t)(BK * 2);
    const size_t hstep = (size_t)HALF * K * 2;
    const size_t tstep = 2 * hstep;
    const unsigned ldsw = (unsigned)wid * 1024u;
    const int aoff = lds_byte(wr * 64 + fr, fq * 8), boff = lds_byte(wc * 32 + fr, fq * 8);
#define PG8_SA(b, h) (((b) * 2 + (h)) * HTB)
#define PG8_SB(b, h) ((4 + (b) * 2 + (h)) * HTB)
#define PG8_STAGE(bufoff, gbase, voff) do { _Pragma("unroll") for (int _i = 0; _i < 2; ++_i) \
        __builtin_amdgcn_global_load_lds((const unsigned*)((const char*)(gbase) + (voff)[_i]), (PG8_LAS unsigned*)(lds + (bufoff) + ldsw + _i * 8192), 16, 0, 0); } while (0)
#define PG8_LDA(dst, b, h) do { _Pragma("unroll") for (int m = 0; m < 4; ++m) _Pragma("unroll") for (int k = 0; k < 2; ++k) dst[m][k] = *(const PG8_LAS bf16x8*)(lds + PG8_SA(b, h) + aoff + m * 2048 + k * 1024); } while (0)
#define PG8_LDB(dst, b, h) do { _Pragma("unroll") for (int n = 0; n < 2; ++n) _Pragma("unroll") for (int k = 0; k < 2; ++k) dst[n][k] = *(const PG8_LAS bf16x8*)(lds + PG8_SB(b, h) + boff + n * 2048 + k * 1024); } while (0)
#define PG8_MMA(ai, bj, At, Bt) do { __builtin_amdgcn_s_setprio(1); _Pragma("unroll") for (int m = 0; m < 4; ++m) _Pragma("unroll") for (int n = 0; n < 2; ++n) _Pragma("unroll") for (int k = 0; k < 2; ++k) \
        acc[ai][bj][m][n] = __builtin_amdgcn_mfma_f32_16x16x32_bf16(Bt[n][k], At[m][k], acc[ai][bj][m][n], 0, 0, 0); __builtin_amdgcn_s_setprio(0); } while (0)
#define PG8_WAIT_V(n) asm volatile("s_waitcnt vmcnt(" #n ")" ::: "memory")
#define PG8_WAIT_L(n) asm volatile("s_waitcnt lgkmcnt(" #n ")" ::: "memory")
#define PG8_BAR __builtin_amdgcn_s_barrier()
#define PG8_SCHED __builtin_amdgcn_sched_barrier(0)
    Unit cur, nxt; int ui = 0;
    if (!S.next(0, cur)) return;
    f32x4 acc[2][2][4][2];
#pragma unroll
    for (int a = 0; a < 2; ++a)
#pragma unroll
        for (int b = 0; b < 2; ++b)
#pragma unroll
            for (int m = 0; m < 4; ++m)
#pragma unroll
                for (int n = 0; n < 2; ++n) acc[a][b][m][n] = (f32x4){0.f, 0.f, 0.f, 0.f};
    bf16x8 At[4][2], B0[2][2], B1[2][2];
    const char* cA = (const char*)g.A + (size_t)cur.pm * tstep; const char* cB = (const char*)g.Bt + (size_t)cur.pn * tstep;
    S.a_ready(cur);
    if constexpr (SP2) {
        PG8_STAGE(PG8_SB(0, 0), cB, voffB); PG8_STAGE(PG8_SB(0, 1), cB + hstep, voffB); PG8_STAGE(PG8_SA(0, 0), cA, voffA); PG8_STAGE(PG8_SA(0, 1), cA + hstep, voffA);
        if (wr == 1) PG8_BAR;
        PG8_WAIT_V(2); PG8_BAR;
        PG8_STAGE(PG8_SB(1, 0), cB + kstep, voffB); PG8_STAGE(PG8_SA(1, 0), cA + kstep, voffA); PG8_STAGE(PG8_SB(1, 1), cB + hstep + kstep, voffB);
        PG8_WAIT_V(6); PG8_BAR;
    } else {
        PG8_STAGE(PG8_SB(0, 0), cB, voffB); PG8_STAGE(PG8_SA(0, 0), cA, voffA); PG8_STAGE(PG8_SB(0, 1), cB + hstep, voffB); PG8_STAGE(PG8_SA(0, 1), cA + hstep, voffA);
        if (wr == 1) PG8_BAR;
        PG8_WAIT_V(4); PG8_BAR;
        PG8_STAGE(PG8_SB(1, 0), cB + kstep, voffB); PG8_STAGE(PG8_SA(1, 0), cA + kstep, voffA); PG8_STAGE(PG8_SB(1, 1), cB + hstep + kstep, voffB);
        PG8_WAIT_V(6); PG8_BAR;
    }
    for (;;) {
        const bool has_next = S.next(ui + 1, nxt);
        const char* nA = has_next ? (const char*)g.A + (size_t)nxt.pm * tstep : cA; const char* nB = has_next ? (const char*)g.Bt + (size_t)nxt.pn * tstep : cB;
#pragma clang loop unroll(disable)
        for (int t = 0; t < nt; t += 2) {
            const bool last = (t == nt - 2);
            const char* a1 = cA + (size_t)(t + 1) * kstep;
            const char* a2 = last ? nA : cA + (size_t)(t + 2) * kstep; const char* b2 = last ? nB : cB + (size_t)(t + 2) * kstep;
            const char* a3 = a2 + kstep; const char* b3 = b2 + kstep;
            if (last && has_next) S.a_ready(nxt);
            if constexpr (SP2) {
            PG8_LDB(B0, 0, 0); PG8_LDB(B1, 0, 1); PG8_SCHED; PG8_LDA(At, 0, 0); PG8_STAGE(PG8_SA(1, 1), a1 + hstep, voffA);
            PG8_WAIT_V(8); PG8_WAIT_L(0); PG8_BAR; PG8_MMA(0, 0, At, B0); PG8_MMA(0, 1, At, B1); PG8_BAR; PG8_SCHED;
            PG8_LDA(At, 0, 1); PG8_STAGE(PG8_SB(0, 0), b2, voffB); PG8_STAGE(PG8_SB(0, 1), b2 + hstep, voffB); PG8_STAGE(PG8_SA(0, 0), a2, voffA);
            PG8_WAIT_V(8); PG8_WAIT_L(0); PG8_BAR; PG8_MMA(1, 0, At, B0); PG8_MMA(1, 1, At, B1); PG8_BAR; PG8_SCHED;
            PG8_LDB(B0, 1, 0); PG8_LDB(B1, 1, 1); PG8_SCHED; PG8_LDA(At, 1, 0); PG8_STAGE(PG8_SA(0, 1), a2 + hstep, voffA);
            PG8_WAIT_V(8); PG8_WAIT_L(0); PG8_BAR; PG8_MMA(0, 0, At, B0); PG8_MMA(0, 1, At, B1); PG8_BAR; PG8_SCHED;
            PG8_LDA(At, 1, 1); PG8_STAGE(PG8_SB(1, 0), b3, voffB); PG8_STAGE(PG8_SB(1, 1), b3 + hstep, voffB); PG8_STAGE(PG8_SA(1, 0), a3, voffA);
            PG8_WAIT_V(8); PG8_WAIT_L(0); PG8_BAR; PG8_MMA(1, 0, At, B0); PG8_MMA(1, 1, At, B1); PG8_BAR; PG8_SCHED;
            } else {
            PG8_LDB(B0, 0, 0); PG8_SCHED; PG8_LDA(At, 0, 0); PG8_STAGE(PG8_SA(1, 1), a1 + hstep, voffA);
            PG8_WAIT_L(8); PG8_BAR; PG8_WAIT_L(0); PG8_MMA(0, 0, At, B0); PG8_BAR; PG8_SCHED;
            PG8_LDB(B1, 0, 1); PG8_STAGE(PG8_SB(0, 0), b2, voffB);
            PG8_BAR; PG8_WAIT_L(0); PG8_MMA(0, 1, At, B1); PG8_BAR;
            PG8_LDA(At, 0, 1); PG8_STAGE(PG8_SA(0, 0), a2, voffA);
            PG8_BAR; PG8_WAIT_L(0); PG8_MMA(1, 0, At, B0); PG8_BAR; PG8_SCHED;
            PG8_STAGE(PG8_SB(0, 1), b2 + hstep, voffB);
            PG8_WAIT_V(6); PG8_BAR; PG8_MMA(1, 1, At, B1); PG8_BAR;
            PG8_LDB(B0, 1, 0); PG8_SCHED; PG8_LDA(At, 1, 0); PG8_STAGE(PG8_SA(0, 1), a2 + hstep, voffA);
            PG8_WAIT_L(8); PG8_BAR; PG8_WAIT_L(0); PG8_MMA(0, 0, At, B0); PG8_BAR; PG8_SCHED;
            PG8_LDB(B1, 1, 1); PG8_STAGE(PG8_SB(1, 0), b3, voffB);
            PG8_BAR; PG8_WAIT_L(0); PG8_MMA(0, 1, At, B1); PG8_BAR;
            PG8_LDA(At, 1, 1); PG8_STAGE(PG8_SA(1, 0), a3, voffA);
            PG8_BAR; PG8_WAIT_L(0); PG8_MMA(1, 0, At, B0); PG8_BAR; PG8_SCHED;
            PG8_STAGE(PG8_SB(1, 1), b3 + hstep, voffB);
            PG8_WAIT_V(6); PG8_BAR; PG8_MMA(1, 1, At, B1); PG8_BAR;
            }
        }
        if constexpr (ALIGN_EPI) { if (wr == 0) PG8_BAR; }
        if constexpr (!Epi::AFTER_DRAIN) { E(acc, cur, wr, wc, fr, fq); S.done(cur); }
        if (!has_next) break;
#pragma unroll
        for (int a = 0; a < 2; ++a)
#pragma unroll
            for (int b = 0; b < 2; ++b)
#pragma unroll
                for (int m = 0; m < 4; ++m)
#pragma unroll
                    for (int n = 0; n < 2; ++n) acc[a][b][m][n] = (f32x4){0.f, 0.f, 0.f, 0.f};
        cur = nxt; cA = nA; cB = nB; ++ui;
        if constexpr (ALIGN_EPI) { if (wr == 1) PG8_BAR; }
    }
    PG8_WAIT_V(0);
    if constexpr (!ALIGN_EPI) { if (wr == 0) PG8_BAR; }
    PG8_BAR;
    if constexpr (Epi::AFTER_DRAIN) { E.fused(acc, cur, wr, wc, fr, fq, lds, wid, lane); S.done(cur); }
#undef PG8_SA
#undef PG8_SB
#undef PG8_STAGE
#undef PG8_LDA
#undef PG8_LDB
#undef PG8_MMA
#undef PG8_WAIT_V
#undef PG8_WAIT_L
#undef PG8_BAR
#undef PG8_SCHED
}
}

using pg8::bf16_t; using pg8::bf16x8; using pg8::f32x4; using pg8::u32x4; using pg8::Unit; using pg8::cvt_pk_bf16; using pg8::gelu_pk; using pg8::f32x2;
#define LAS __attribute__((address_space(3)))
typedef float f32x16 __attribute__((ext_vector_type(16)));
typedef unsigned u32x2 __attribute__((ext_vector_type(2)));

#ifndef MK_ONE_LAUNCH
#define MK_ONE_LAUNCH 0
#endif

constexpr int D = 1024, NTOK = 8192, NCTX = 4096, NKEY = 10240, INW = 1696, INP = 1792, DFF = 2816, DFF2 = 5632;
constexpr int SSQS = 36;
constexpr float EPS = 1e-6f;
constexpr float QSCALE = 0.10206207261596575f * 1.4426950408889634f;
constexpr int NPH = 12;
constexpr size_t MiB = (size_t)1 << 20;
constexpr size_t WS_WT1 = 0, WS_WTQ = 4 * MiB, WS_WTKV = 5 * MiB, WS_WTO = 6 * MiB, WS_WTUP = 8 * MiB, WS_WTDN = 19 * MiB, WS_MODS = 25 * MiB,
                 WS_SSQ1 = 26 * MiB, WS_ROPE = 28 * MiB, WS_SSQA = 30 * MiB, WS_KR = 31 * MiB, WS_KVRAW = 32 * MiB, WS_H = 36 * MiB,
                 WS_QLAT = 64 * MiB, WS_KVA = 70 * MiB, WS_GVT = 75 * MiB, WS_GU = 83 * MiB, WS_Q = 91 * MiB, WS_KN = 103 * MiB, WS_VT = 113 * MiB,
                 WS_AO = 123 * MiB, WS_MIX = 139 * MiB, WS_AUP = 64 * MiB, WS_X1 = 160 * MiB, WS_G = 192 * MiB, WS_END = 236 * MiB;
constexpr int LDS_BYTES = 147456;

struct Args { const float* in[26]; float* out; unsigned char* ws; int ph_lo, ph_hi; };

__device__ __forceinline__ unsigned f2bf(float f) { unsigned u = __float_as_uint(f); return (u + 0x7fffu + ((u >> 16) & 1u)) >> 16; }
__device__ __forceinline__ float bf2f(unsigned short b) { return __uint_as_float((unsigned)b << 16); }
__device__ __forceinline__ float wave_sum(float v) {
#pragma unroll
    for (int o = 1; o < 64; o <<= 1) v += __shfl_xor(v, o);
    return v;
}
__device__ __forceinline__ u32x4 pack8(f32x4 a, f32x4 b) { u32x4 w; w.x = cvt_pk_bf16(a[0], a[1]); w.y = cvt_pk_bf16(a[2], a[3]); w.z = cvt_pk_bf16(b[0], b[1]); w.w = cvt_pk_bf16(b[2], b[3]); return w; }
__device__ __forceinline__ f32x4 gelu4(f32x4 v) { f32x2 a = gelu_pk((f32x2){v[0], v[1]}), b = gelu_pk((f32x2){v[2], v[3]}); return (f32x4){a.x, a.y, b.x, b.y}; }
__device__ __forceinline__ float dot4(f32x4 a) { return (a[0] * a[0] + a[1] * a[1]) + (a[2] * a[2] + a[3] * a[3]); }
__device__ __forceinline__ int mod_of_row(int row) { return row < NCTX ? 0 : 1 + ((row - NCTX) >> 10); }
__device__ __forceinline__ void rope8(f32x4& v0, f32x4& v1, const float* tab, int fq) {
    const float sg = (fq & 1) ? 1.f : -1.f;
#pragma unroll
    for (int e = 0; e < 4; ++e) {
        const float o0 = __shfl_xor(v0[e], 16), o1 = __shfl_xor(v1[e], 16);
        const float c0 = tab[2 * e], s0 = tab[2 * e + 1], c1 = tab[2 * (e + 4)], s1 = tab[2 * (e + 4) + 1];
        v0[e] = v0[e] * c0 + sg * o0 * s0; v1[e] = v1[e] * c1 + sg * o1 * s1;
    }
}

struct Epi1 {
    static constexpr bool PERM = true, AFTER_DRAIN = false;
    bf16_t* qlat; bf16_t* kva; float* kvraw; bf16_t* gvt; bf16_t* gu; bf16_t* kr; float* ssq; float* out_krope; const float* qg; const float* kvg; const float* rope;
    __device__ __forceinline__ void operator()(const f32x4 (&acc)[2][2][4][2], const Unit& u, int wr, int wc, int fr, int fq) const {
        const int cl = wc * 32 + fq * 8;
#pragma unroll
        for (int bj = 0; bj < 2; ++bj) {
            const int hc = u.pn * 2 + bj;
            if (hc < 5) {
                const bool isq = hc < 3;
                const float* g = isq ? qg + hc * 128 + cl : kvg + (hc - 3) * 128 + cl;
                const f32x4 g0 = *(const f32x4*)g, g1 = *(const f32x4*)(g + 4);
#pragma unroll
                for (int ai = 0; ai < 2; ++ai)
#pragma unroll
                    for (int m = 0; m < 4; ++m) {
                        const int row = u.pm * 256 + ai * 128 + wr * 64 + m * 16 + fr;
                        const f32x4 v0 = acc[ai][bj][m][0], v1 = acc[ai][bj][m][1];
                        float s = dot4(v0) + dot4(v1); s += __shfl_xor(s, 16); s += __shfl_xor(s, 32);
                        if (fq == 0) ssq[(size_t)row * SSQS + hc * 4 + wc] = s;
                        if (!isq && row < NCTX) { float* p = kvraw + (size_t)row * 256 + (hc - 3) * 128 + cl; *(f32x4*)p = v0; *(f32x4*)(p + 4) = v1; }
                        const u32x4 w = pack8(v0 * g0, v1 * g1);
                        bf16_t* dst = isq ? qlat + (size_t)row * 384 + hc * 128 + cl : kva + (size_t)row * 256 + (hc - 3) * 128 + cl;
                        *(u32x4*)dst = w;
                    }
            } else if (hc < 9) {
                const int gi = hc - 5;
#pragma unroll
                for (int ai = 0; ai < 2; ++ai)
#pragma unroll
                    for (int m = 0; m < 4; ++m) {
                        const int row = u.pm * 256 + ai * 128 + wr * 64 + m * 16 + fr;
                        const f32x4 v0 = gelu4(acc[ai][bj][m][0]), v1 = gelu4(acc[ai][bj][m][1]);
                        float s = dot4(v0) + dot4(v1); s += __shfl_xor(s, 16); s += __shfl_xor(s, 32);
                        if (fq == 0) ssq[(size_t)row * SSQS + hc * 4 + wc] = s;
                        bf16_t* dst = gvt + (size_t)(gi * 128 + cl) * NTOK + row;
#pragma unroll
                        for (int e = 0; e < 4; ++e) { dst[(size_t)e * NTOK] = (bf16_t)f2bf(v0[e]); dst[(size_t)(e + 4) * NTOK] = (bf16_t)f2bf(v1[e]); }
                    }
            } else if (hc < 13) {
#pragma unroll
                for (int ai = 0; ai < 2; ++ai)
#pragma unroll
                    for (int m = 0; m < 4; ++m) {
                        const int row = u.pm * 256 + ai * 128 + wr * 64 + m * 16 + fr;
                        const f32x4 v0 = gelu4(acc[ai][bj][m][0]), v1 = gelu4(acc[ai][bj][m][1]);
                        *(u32x4*)(gu + (size_t)row * 512 + (hc - 9) * 128 + cl) = pack8(v0, v1);
                    }
            } else if (wc == 0) {
                const bool lat = u.pm >= 16;
#pragma unroll
                for (int ai = 0; ai < 2; ++ai)
#pragma unroll
                    for (int m = 0; m < 4; ++m) {
                        const int row = u.pm * 256 + ai * 128 + wr * 64 + m * 16 + fr;
                        f32x4 v0 = acc[ai][bj][m][0], v1 = acc[ai][bj][m][1];
                        int key = row;
                        if (lat) {
                            const int t = (row - NCTX) & 1023, b = (row - NCTX) >> 10;
                            key = NCTX + 1536 * b + 512 + t;
                            const int p = (fq < 2) ? (t >> 6) : (t & 63);
                            rope8(v0, v1, rope + p * 16, fq);
                        } else { float* p = out_krope + (size_t)row * 32 + fq * 8; *(f32x4*)p = v0; *(f32x4*)(p + 4) = v1; }
                        *(u32x4*)(kr + (size_t)key * 32 + fq * 8) = pack8(v0, v1);
                    }
            }
        }
    }
};
struct Epi2 {
    static constexpr bool PERM = true, AFTER_DRAIN = false;
    bf16_t* q; const float* ssq; const float* rope;
    __device__ __forceinline__ void operator()(const f32x4 (&acc)[2][2][4][2], const Unit& u, int wr, int wc, int fr, int fq) const {
        const bool lat = u.pm >= 16;
#pragma unroll
        for (int ai = 0; ai < 2; ++ai)
#pragma unroll
            for (int m = 0; m < 4; ++m) {
                const int row = u.pm * 256 + ai * 128 + wr * 64 + m * 16 + fr;
                const f32x4* sp = (const f32x4*)(ssq + (size_t)row * SSQS);
                const f32x4 a = sp[0], b = sp[1], c = sp[2];
                const float tot = ((a[0] + a[1]) + (a[2] + a[3])) + ((b[0] + b[1]) + (b[2] + b[3])) + ((c[0] + c[1]) + (c[2] + c[3]));
                const float rs = __builtin_amdgcn_rsqf(tot * (1.f / 384.f) + EPS) * QSCALE;
                const int t = (row - NCTX) & 1023;
#pragma unroll
                for (int bj = 0; bj < 2; ++bj) {
                    const int col0 = u.pn * 256 + bj * 128 + wc * 32;
                    f32x4 v0 = acc[ai][bj][m][0] * rs, v1 = acc[ai][bj][m][1] * rs;
                    if (lat && (col0 % 96) == 64) { const int p = (fq < 2) ? (t >> 6) : (t & 63); rope8(v0, v1, rope + p * 16, fq); }
                    *(u32x4*)(q + (size_t)row * 768 + col0 + fq * 8) = pack8(v0, v1);
                }
                asm volatile("" ::: "memory");
            }
    }
};
struct Epi3 {
    static constexpr bool PERM = true, AFTER_DRAIN = false;
    bf16_t* kn; bf16_t* vt; const float* ssq;
    __device__ __forceinline__ void operator()(const f32x4 (&acc)[2][2][4][2], const Unit& u, int wr, int wc, int fr, int fq) const {
#pragma unroll
        for (int ai = 0; ai < 2; ++ai)
#pragma unroll
            for (int m = 0; m < 4; ++m) {
                const int row = u.pm * 256 + ai * 128 + wr * 64 + m * 16 + fr;
                float rs = 1.f; int key;
                if (u.pm < 32) {
                    const f32x4* sp = (const f32x4*)(ssq + (size_t)row * SSQS + 12);
                    const f32x4 a = sp[0], b = sp[1];
                    const float tot = ((a[0] + a[1]) + (a[2] + a[3])) + ((b[0] + b[1]) + (b[2] + b[3]));
                    rs = __builtin_amdgcn_rsqf(tot * (1.f / 256.f) + EPS);
                    key = (u.pm < 16) ? row : NCTX + 1536 * ((row - NCTX) >> 10) + 512 + ((row - NCTX) & 1023);
                } else { const int j = row - NTOK; key = NCTX + 1536 * (j >> 9) + (j & 511); }
#pragma unroll
                for (int bj = 0; bj < 2; ++bj) {
                    const int h = u.pn * 2 + bj;
                    const f32x4 v0 = acc[ai][bj][m][0] * rs, v1 = acc[ai][bj][m][1] * rs;
                    if (wc < 2) *(u32x4*)(kn + ((size_t)h * NKEY + key) * 64 + wc * 32 + fq * 8) = pack8(v0, v1);
                    else { bf16_t* dst = vt + ((size_t)h * 64 + (wc - 2) * 32 + fq * 8) * NKEY + key;
#pragma unroll
                        for (int e = 0; e < 4; ++e) { dst[(size_t)e * NKEY] = (bf16_t)f2bf(v0[e]); dst[(size_t)(e + 4) * NKEY] = (bf16_t)f2bf(v1[e]); } }
                }
                asm volatile("" ::: "memory");
            }
    }
};
struct EpiRes {
    static constexpr bool PERM = true, AFTER_DRAIN = false;
    const float* base_lo; const float* base_hi; float* out; const float* gate;
    __device__ __forceinline__ void operator()(const f32x4 (&acc)[2][2][4][2], const Unit& u, int wr, int wc, int fr, int fq) const {
        const float* base = (u.pm < 16) ? base_lo : base_hi;
        const float* gp = gate + (size_t)mod_of_row(u.pm * 256) * 6144;
#pragma unroll
        for (int bj = 0; bj < 2; ++bj) {
            const int col = u.pn * 256 + bj * 128 + wc * 32 + fq * 8;
            const f32x4 g0 = *(const f32x4*)(gp + col), g1 = *(const f32x4*)(gp + col + 4);
#pragma unroll
            for (int ai = 0; ai < 2; ++ai)
#pragma unroll
                for (int m = 0; m < 4; ++m) {
                    const int row = u.pm * 256 + ai * 128 + wr * 64 + m * 16 + fr;
                    const float* bp = base + (size_t)row * D + col; float* op = out + (size_t)row * D + col;
                    const f32x4 b0 = *(const f32x4*)bp, b1 = *(const f32x4*)(bp + 4);
                    *(f32x4*)op = b0 + g0 * acc[ai][bj][m][0]; *(f32x4*)(op + 4) = b1 + g1 * acc[ai][bj][m][1];
                }
        }
    }
};
struct EpiPlain {
    static constexpr bool PERM = true, AFTER_DRAIN = false;
    bf16_t* O; int ldc;
    __device__ __forceinline__ void operator()(const f32x4 (&acc)[2][2][4][2], const Unit& u, int wr, int wc, int fr, int fq) const {
#pragma unroll
        for (int ai = 0; ai < 2; ++ai)
#pragma unroll
            for (int m = 0; m < 4; ++m) {
                const int row = u.pm * 256 + ai * 128 + wr * 64 + m * 16 + fr;
#pragma unroll
                for (int bj = 0; bj < 2; ++bj)
                    *(u32x4*)(O + (size_t)row * ldc + u.pn * 256 + bj * 128 + wc * 32 + fq * 8) = pack8(acc[ai][bj][m][0], acc[ai][bj][m][1]);
            }
    }
};

__device__ __forceinline__ void transpose_item(const float* W, int N, int K, bf16_t* WT, int src_n0, int dst_n0, int k0, LAS float* scr, int lane) {
#pragma unroll 8
    for (int i = 0; i < 32; ++i) { const int kk = 2 * i + (lane >> 5); scr[kk * 33 + (lane & 31)] = W[(size_t)(k0 + kk) * N + src_n0 + (lane & 31)]; }
    asm volatile("s_waitcnt lgkmcnt(0)" ::: "memory");
    const int c = lane & 7;
#pragma unroll
    for (int j = 0; j < 4; ++j) { const int n = (lane >> 3) + 8 * j; const LAS float* s = scr + (8 * c) * 33 + n;
        u32x4 o; o.x = cvt_pk_bf16(s[0 * 33], s[1 * 33]); o.y = cvt_pk_bf16(s[2 * 33], s[3 * 33]); o.z = cvt_pk_bf16(s[4 * 33], s[5 * 33]); o.w = cvt_pk_bf16(s[6 * 33], s[7 * 33]);
        *(u32x4*)(WT + (size_t)(dst_n0 + n) * K + k0 + 8 * c) = o; }
    asm volatile("s_waitcnt lgkmcnt(0)" ::: "memory");
}
__device__ __forceinline__ int win_src_col(int j) { return j < 640 ? j : (j < 1152 ? 1184 + (j - 640) : (j < 1664 ? 672 + (j - 1152) : 640 + (j - 1664))); }

template <bool FINAL> __device__ __forceinline__ void norm_rows(const float* src_lo, const float* src_hi, const float* g, const float* mods, int off_shift, int off_scale, bf16_t* dstb, float* dstf, int gw, int ngw, int lane) {
    for (int row = gw; row < NTOK; row += ngw) {
        const float* xr = (row < NCTX ? src_lo : src_hi) + (size_t)row * D;
        f32x4 v[4]; float s = 0.f;
#pragma unroll
        for (int j = 0; j < 4; ++j) { v[j] = *(const f32x4*)(xr + 4 * lane + 256 * j); s += dot4(v[j]); }
        const float rstd = 1.0f / sqrtf(wave_sum(s) * (1.f / D) + EPS);
        const float* mp = mods + (size_t)mod_of_row(row) * 6144;
#pragma unroll
        for (int j = 0; j < 4; ++j) {
            const int col = 4 * lane + 256 * j;
            const f32x4 gg = *(const f32x4*)(g + col);
            if (FINAL) { *(f32x4*)(dstf + (size_t)row * D + col) = v[j] * rstd * gg; }
            else {
                const f32x4 sh = *(const f32x4*)(mp + off_shift + col), sc = *(const f32x4*)(mp + off_scale + col);
                const f32x4 o = v[j] * rstd * gg * (sc + 1.f) + sh;
                u32x2 w; w.x = cvt_pk_bf16(o[0], o[1]); w.y = cvt_pk_bf16(o[2], o[3]);
                *(u32x2*)(dstb + (size_t)row * D + col) = w;
            }
        }
    }
}

constexpr int AT_KSTR = 208, AT_VSTR = 136, AT_KBYTES = 64 * AT_KSTR, AT_VBYTES = 64 * AT_VSTR, AT_BUF = AT_KBYTES + AT_VBYTES;
__device__ __forceinline__ void attn_unit(LAS unsigned char* lds, const bf16_t* Q, const bf16_t* KN, const bf16_t* KR, const bf16_t* VT, float* AO, float* SSQA,
                                          int qrow0, int head, int kbase, int nkeys) {
    const int tid = threadIdx.x, lane = tid & 63, wid = tid >> 6, r32 = lane & 31, hi = lane >> 5;
    const int qg = wid & 3, kh = wid >> 2, ht = tid & 255;
    const int qrow = qrow0 + qg * 32 + r32;
    bf16x8 qf[6];
    { const bf16_t* qp = Q + (size_t)qrow * 768 + head * 96 + hi * 8;
#pragma unroll
      for (int d0 = 0; d0 < 6; ++d0) qf[d0] = *(const bf16x8*)(qp + d0 * 16); }
    const int nk2 = nkeys >> 1, k0 = kbase + kh * nk2, NT = nk2 >> 6;
    const bf16_t* knp = KN + ((size_t)head * NKEY + k0) * 64;
    const bf16_t* krp = KR + (size_t)k0 * 32;
    const bf16_t* vtp = VT + (size_t)head * 64 * NKEY + k0;
    u32x4 gk0, gk1, gr, gv0, gv1;
#define AT_LOAD(t) do { const int kk = (t) * 64; \
        gk0 = *(const u32x4*)(knp + (size_t)(kk + (ht >> 3)) * 64 + (ht & 7) * 8); gk1 = *(const u32x4*)(knp + (size_t)(kk + 32 + (ht >> 3)) * 64 + (ht & 7) * 8); \
        gr = *(const u32x4*)(krp + (size_t)(kk + (ht >> 2)) * 32 + (ht & 3) * 8); \
        gv0 = *(const u32x4*)(vtp + (size_t)(ht >> 3) * NKEY + kk + (ht & 7) * 8); gv1 = *(const u32x4*)(vtp + (size_t)(32 + (ht >> 3)) * NKEY + kk + (ht & 7) * 8); } while (0)
#define AT_STORE(b) do { LAS unsigned char* kb_ = lds + (kh * 2 + (b)) * AT_BUF; LAS unsigned char* vb_ = kb_ + AT_KBYTES; \
        *(LAS u32x4*)(kb_ + (ht >> 3) * AT_KSTR + (ht & 7) * 16) = gk0; *(LAS u32x4*)(kb_ + (32 + (ht >> 3)) * AT_KSTR + (ht & 7) * 16) = gk1; \
        *(LAS u32x4*)(kb_ + (ht >> 2) * AT_KSTR + 128 + (ht & 3) * 16) = gr; \
        *(LAS u32x2*)(vb_ + (ht >> 3) * AT_VSTR + (ht & 7) * 16) = (u32x2){gv0.x, gv0.y}; *(LAS u32x2*)(vb_ + (ht >> 3) * AT_VSTR + (ht & 7) * 16 + 8) = (u32x2){gv0.z, gv0.w}; \
        *(LAS u32x2*)(vb_ + (32 + (ht >> 3)) * AT_VSTR + (ht & 7) * 16) = (u32x2){gv1.x, gv1.y}; *(LAS u32x2*)(vb_ + (32 + (ht >> 3)) * AT_VSTR + (ht & 7) * 16 + 8) = (u32x2){gv1.z, gv1.w}; } while (0)
    float m_run = -1e30f, l_run = 0.f;
    f32x16 o0, o1;
#pragma unroll
    for (int r = 0; r < 16; ++r) { o0[r] = 0.f; o1[r] = 0.f; }
    AT_LOAD(0);
    for (int t = 0; t < NT; ++t) {
        AT_STORE(t & 1);
        __syncthreads();
        if (t + 1 < NT) AT_LOAD(t + 1);
        const LAS unsigned char* kb = lds + (kh * 2 + (t & 1)) * AT_BUF; const LAS unsigned char* vb = kb + AT_KBYTES;
        f32x16 s0, s1;
#pragma unroll
        for (int r = 0; r < 16; ++r) { s0[r] = 0.f; s1[r] = 0.f; }
#pragma unroll
        for (int d0 = 0; d0 < 6; ++d0) {
            const bf16x8 k0f = *(const LAS bf16x8*)(kb + r32 * AT_KSTR + d0 * 32 + hi * 16);
            const bf16x8 k1f = *(const LAS bf16x8*)(kb + (32 + r32) * AT_KSTR + d0 * 32 + hi * 16);
            s0 = __builtin_amdgcn_mfma_f32_32x32x16_bf16(k0f, qf[d0], s0, 0, 0, 0);
            s1 = __builtin_amdgcn_mfma_f32_32x32x16_bf16(k1f, qf[d0], s1, 0, 0, 0);
        }
        float mx = fmaxf(s0[0], s1[0]);
#pragma unroll
        for (int r = 1; r < 16; ++r) mx = fmaxf(mx, fmaxf(s0[r], s1[r]));
        mx = fmaxf(mx, __shfl_xor(mx, 32));
        const float mn = fmaxf(m_run, mx), alpha = __builtin_amdgcn_exp2f(m_run - mn);
        m_run = mn;
        float ls = 0.f;
#pragma unroll
        for (int r = 0; r < 16; ++r) { s0[r] = __builtin_amdgcn_exp2f(s0[r] - mn); s1[r] = __builtin_amdgcn_exp2f(s1[r] - mn); ls += s0[r] + s1[r]; }
        l_run = l_run * alpha + ls;
#pragma unroll
        for (int r = 0; r < 16; ++r) { o0[r] *= alpha; o1[r] *= alpha; }
        u32x4 pb[4];
        pb[0] = pack8((f32x4){s0[0], s0[1], s0[2], s0[3]}, (f32x4){s0[4], s0[5], s0[6], s0[7]});
        pb[1] = pack8((f32x4){s0[8], s0[9], s0[10], s0[11]}, (f32x4){s0[12], s0[13], s0[14], s0[15]});
        pb[2] = pack8((f32x4){s1[0], s1[1], s1[2], s1[3]}, (f32x4){s1[4], s1[5], s1[6], s1[7]});
        pb[3] = pack8((f32x4){s1[8], s1[9], s1[10], s1[11]}, (f32x4){s1[12], s1[13], s1[14], s1[15]});
#pragma unroll
        for (int ks = 0; ks < 4; ++ks) {
            const bf16x8 pf = __builtin_bit_cast(bf16x8, pb[ks]);
            const LAS unsigned char* vp = vb + r32 * AT_VSTR + ks * 32 + hi * 8;
            const u32x2 a0 = *(const LAS u32x2*)(vp), a1 = *(const LAS u32x2*)(vp + 16);
            const u32x2 c0 = *(const LAS u32x2*)(vp + 32 * AT_VSTR), c1 = *(const LAS u32x2*)(vp + 32 * AT_VSTR + 16);
            o0 = __builtin_amdgcn_mfma_f32_32x32x16_bf16(__builtin_bit_cast(bf16x8, (u32x4){a0.x, a0.y, a1.x, a1.y}), pf, o0, 0, 0, 0);
            o1 = __builtin_amdgcn_mfma_f32_32x32x16_bf16(__builtin_bit_cast(bf16x8, (u32x4){c0.x, c0.y, c1.x, c1.y}), pf, o1, 0, 0, 0);
        }
    }
#undef AT_LOAD
#undef AT_STORE
    l_run += __shfl_xor(l_run, 32);
    __syncthreads();
    LAS float* cb = (LAS float*)lds + (qg * 64 + lane) * 35;
    if (kh == 1) {
        cb[0] = m_run; cb[1] = l_run;
#pragma unroll
        for (int r = 0; r < 16; ++r) { cb[2 + r] = o0[r]; cb[18 + r] = o1[r]; }
    }
    __syncthreads();
    if (kh == 0) {
        const float m1 = cb[0], l1 = cb[1];
        const float mn = fmaxf(m_run, m1), a0 = __builtin_amdgcn_exp2f(m_run - mn), a1 = __builtin_amdgcn_exp2f(m1 - mn);
        const float inv = 1.0f / (l_run * a0 + l1 * a1);
        float ss = 0.f;
#pragma unroll
        for (int r = 0; r < 16; ++r) { o0[r] = (o0[r] * a0 + cb[2 + r] * a1) * inv; o1[r] = (o1[r] * a0 + cb[18 + r] * a1) * inv; ss += o0[r] * o0[r] + o1[r] * o1[r]; }
        ss += __shfl_xor(ss, 32);
        float* op = AO + (size_t)qrow * 512 + head * 64 + 4 * hi;
#pragma unroll
        for (int g4 = 0; g4 < 4; ++g4) {
            *(f32x4*)(op + 8 * g4) = (f32x4){o0[4 * g4], o0[4 * g4 + 1], o0[4 * g4 + 2], o0[4 * g4 + 3]};
            *(f32x4*)(op + 32 + 8 * g4) = (f32x4){o1[4 * g4], o1[4 * g4 + 1], o1[4 * g4 + 2], o1[4 * g4 + 3]};
        }
        if (hi == 0) SSQA[(size_t)qrow * 8 + head] = ss;
    }
    __syncthreads();
}

__device__ __forceinline__ void spatial_unit(LAS unsigned char* lds, int chunk, const bf16_t* GVT, const bf16_t* GU, const float* SSQ1, const float* w_s, const float* b_s,
                                             const float* vg, const float* og, bf16_t* MIX) {
    const int tid = threadIdx.x, lane = tid & 63, wid = tid >> 6, r32 = lane & 31, hi = lane >> 5;
    const int ih = wid & 3, ch = wid >> 2, t0 = chunk * 128, i = ih * 32 + r32;
    LAS float* rv = (LAS float*)lds;
    LAS float* red = rv + 512;
    { const int j = tid >> 2, g = tid & 3; const f32x4 p = *(const f32x4*)(SSQ1 + (size_t)(t0 + j) * SSQS + 20 + 4 * g);
      rv[tid] = __builtin_amdgcn_rsqf(((p[0] + p[1]) + (p[2] + p[3])) * (1.f / 128.f) + EPS); }
    __syncthreads();
    f32x16 acc[4][2]; float ssq = 0.f;
#pragma unroll
    for (int g = 0; g < 4; ++g) {
#pragma unroll
        for (int r = 0; r < 16; ++r) { acc[g][0][r] = 0.f; acc[g][1][r] = 0.f; }
#pragma unroll
        for (int ks = 0; ks < 8; ++ks) {
            const int j0 = 16 * ks + 8 * hi;
            const float* wp = w_s + ((size_t)g * 128 + i) * 128 + j0;
            f32x4 w0 = *(const f32x4*)wp, w1 = *(const f32x4*)(wp + 4);
#pragma unroll
            for (int e = 0; e < 4; ++e) { w0[e] *= rv[(j0 + e) * 4 + g]; w1[e] *= rv[(j0 + 4 + e) * 4 + g]; }
            const bf16x8 bf = __builtin_bit_cast(bf16x8, pack8(w0, w1));
#pragma unroll
            for (int ct = 0; ct < 2; ++ct) {
                const int c = g * 128 + ch * 64 + ct * 32 + r32;
                const bf16x8 af = *(const bf16x8*)(GVT + (size_t)c * NTOK + t0 + j0);
                acc[g][ct] = __builtin_amdgcn_mfma_f32_32x32x16_bf16(af, bf, acc[g][ct], 0, 0, 0);
            }
        }
        const float bs = b_s[g * 128 + i];
#pragma unroll
        for (int ct = 0; ct < 2; ++ct)
#pragma unroll
            for (int g4 = 0; g4 < 4; ++g4) {
                const int cb = g * 128 + ch * 64 + ct * 32 + 8 * g4 + 4 * hi;
                const f32x4 vgv = *(const f32x4*)(vg + cb);
                const u32x2 guw = *(const u32x2*)(GU + (size_t)(t0 + i) * 512 + cb);
                const float gu0 = __uint_as_float(guw.x << 16), gu1 = __uint_as_float(guw.x & 0xffff0000u), gu2 = __uint_as_float(guw.y << 16), gu3 = __uint_as_float(guw.y & 0xffff0000u);
                float o;
                o = gu0 * (acc[g][ct][4 * g4 + 0] * vgv[0] + bs); acc[g][ct][4 * g4 + 0] = o; ssq += o * o;
                o = gu1 * (acc[g][ct][4 * g4 + 1] * vgv[1] + bs); acc[g][ct][4 * g4 + 1] = o; ssq += o * o;
                o = gu2 * (acc[g][ct][4 * g4 + 2] * vgv[2] + bs); acc[g][ct][4 * g4 + 2] = o; ssq += o * o;
                o = gu3 * (acc[g][ct][4 * g4 + 3] * vgv[3] + bs); acc[g][ct][4 * g4 + 3] = o; ssq += o * o;
            }
    }
    ssq += __shfl_xor(ssq, 32);
    if (hi == 0) red[i * 2 + ch] = ssq;
    __syncthreads();
    const float rs = __builtin_amdgcn_rsqf((red[i * 2] + red[i * 2 + 1]) * (1.f / 512.f) + EPS);
#pragma unroll
    for (int g = 0; g < 4; ++g)
#pragma unroll
        for (int ct = 0; ct < 2; ++ct)
#pragma unroll
            for (int g4 = 0; g4 < 4; ++g4) {
                const int cb = g * 128 + ch * 64 + ct * 32 + 8 * g4 + 4 * hi;
                const f32x4 ogv = *(const f32x4*)(og + cb);
                u32x2 w; w.x = cvt_pk_bf16(acc[g][ct][4 * g4] * rs * ogv[0], acc[g][ct][4 * g4 + 1] * rs * ogv[1]);
                w.y = cvt_pk_bf16(acc[g][ct][4 * g4 + 2] * rs * ogv[2], acc[g][ct][4 * g4 + 3] * rs * ogv[3]);
                *(u32x2*)(MIX + (size_t)(t0 + i) * D + 512 + cb) = w;
            }
    __syncthreads();
}

#define BFLO(w) __uint_as_float((w) << 16)
#define BFHI(w) __uint_as_float((w) & 0xffff0000u)
__global__ void __launch_bounds__(512, 2) mk_fwd(Args a) {
    extern __shared__ __attribute__((aligned(16))) unsigned char lds_raw[];
    LAS unsigned char* lds = (LAS unsigned char*)lds_raw;
    cg::grid_group grid = cg::this_grid();
    const int tid = threadIdx.x, lane = tid & 63, wave = __builtin_amdgcn_readfirstlane(tid >> 6);
    const int G = gridDim.x, bx = blockIdx.x;
    const int vcu = (G % 8 == 0) ? (bx % 8) * (G / 8) + bx / 8 : bx;
    const int gw = bx * 8 + wave, ngw = G * 8;
    const int lo = a.ph_lo, hi_ = a.ph_hi;
    unsigned char* ws = a.ws;
    const float* xp = a.in[0]; const float* xs = a.in[1];
    bf16_t* WT1 = (bf16_t*)(ws + WS_WT1); bf16_t* WTQ = (bf16_t*)(ws + WS_WTQ); bf16_t* WTKV = (bf16_t*)(ws + WS_WTKV); bf16_t* WTO = (bf16_t*)(ws + WS_WTO);
    bf16_t* WTUP = (bf16_t*)(ws + WS_WTUP); bf16_t* WTDN = (bf16_t*)(ws + WS_WTDN);
    float* MODS = (float*)(ws + WS_MODS); float* SSQ1 = (float*)(ws + WS_SSQ1); float* ROPE = (float*)(ws + WS_ROPE); float* SSQA = (float*)(ws + WS_SSQA);
    bf16_t* KR = (bf16_t*)(ws + WS_KR); float* KVRAW = (float*)(ws + WS_KVRAW); bf16_t* H = (bf16_t*)(ws + WS_H);
    bf16_t* QLAT = (bf16_t*)(ws + WS_QLAT); bf16_t* KVA = (bf16_t*)(ws + WS_KVA); bf16_t* GVT = (bf16_t*)(ws + WS_GVT); bf16_t* GU = (bf16_t*)(ws + WS_GU);
    bf16_t* Qb = (bf16_t*)(ws + WS_Q); bf16_t* KN = (bf16_t*)(ws + WS_KN); bf16_t* VT = (bf16_t*)(ws + WS_VT); float* AO = (float*)(ws + WS_AO);
    bf16_t* MIX = (bf16_t*)(ws + WS_MIX); bf16_t* AUP = (bf16_t*)(ws + WS_AUP); float* X1 = (float*)(ws + WS_X1); bf16_t* Gb = (bf16_t*)(ws + WS_G);
    float* out_y = a.out; float* out_ckv = a.out + (size_t)NTOK * D; float* out_krope = out_ckv + (size_t)NCTX * 256;
#ifndef MK_SKIP
#define MK_SKIP 0
#endif
#define IN(k) (!((MK_SKIP >> (k)) & 1) && lo <= (k) && (k) < hi_)
#define SEAM(k) do { if (IN(k) && IN((k) + 1)) grid.sync(); } while (0)

    if (IN(0)) {
        if (bx < 192) {
            LAS float* scond = (LAS float*)lds;
            LAS float* red = (LAS float*)(lds + 24576);
            for (int idx = tid; idx < 5 * 1024; idx += 512) { const int c = idx >> 10, k = idx & 1023; const float v = (c == 0) ? a.in[5][k] : a.in[4][(c - 1) * 1024 + k]; scond[idx] = v / (1.f + __expf(-v)); }
            __syncthreads();
            float acc5[5] = {0.f, 0.f, 0.f, 0.f, 0.f};
            const float* wp = a.in[6] + (size_t)(128 * wave + (lane >> 5)) * 6144 + 32 * bx + (lane & 31);
#pragma unroll 8
            for (int it = 0; it < 64; ++it) { const float w = wp[(size_t)it * 2 * 6144]; const int k = 128 * wave + 2 * it + (lane >> 5);
#pragma unroll
                for (int c = 0; c < 5; ++c) acc5[c] += scond[c * 1024 + k] * w; }
#pragma unroll
            for (int c = 0; c < 5; ++c) { acc5[c] += __shfl_xor(acc5[c], 32); if (lane < 32) red[(wave * 5 + c) * 32 + lane] = acc5[c]; }
            __syncthreads();
            if (tid < 160) { const int c = tid >> 5, col = tid & 31; float s = 0.f;
#pragma unroll
                for (int w = 0; w < 8; ++w) s += red[(w * 5 + c) * 32 + col];
                MODS[c * 6144 + 32 * bx + col] = s + a.in[7][32 * bx + col]; }
            __syncthreads();
        }
        {
            LAS float* scr = (LAS float*)(lds + 32768 + wave * 8448);
            constexpr int I1 = 16 * 53, I2 = 6 * 24, I3 = 4 * 32, I4 = 16 * 32, I5 = 16 * 176, I6 = 44 * 32, NIT = I1 + I2 + I3 + I4 + I5 + I6;
            for (int it = gw; it < NIT; it += ngw) {
                int r = it;
                if (r < I1) { const int kb = r / 53, nb = r % 53; transpose_item(a.in[9], INW, 1024, WT1, win_src_col(32 * nb), 32 * nb, 64 * kb, scr, lane); continue; } r -= I1;
                if (r < I2) { const int kb = r / 24, nb = r % 24; transpose_item(a.in[11], 768, 384, WTQ, 32 * nb, 32 * nb, 64 * kb, scr, lane); continue; } r -= I2;
                if (r < I3) { const int kb = r / 32, nb = r % 32; transpose_item(a.in[13], 1024, 256, WTKV, 32 * nb, 32 * nb, 64 * kb, scr, lane); continue; } r -= I3;
                if (r < I4) { const int kb = r / 32, nb = r % 32; transpose_item(a.in[19], 1024, 1024, WTO, 32 * nb, 32 * nb, 64 * kb, scr, lane); continue; } r -= I4;
                if (r < I5) { const int kb = r / 176, nb = r % 176; transpose_item(a.in[21], DFF2, 1024, WTUP, 32 * nb, 32 * nb, 64 * kb, scr, lane); continue; } r -= I5;
                { const int kb = r / 32, nb = r % 32; transpose_item(a.in[24], 1024, DFF, WTDN, 32 * nb, 32 * nb, 64 * kb, scr, lane); }
            }
        }
        const int gt = bx * 512 + tid, ngt = G * 512;
        for (int idx = gt; idx < (INP - INW) * 1024 / 8; idx += ngt) *(u32x4*)(WT1 + (size_t)INW * 1024 + (size_t)idx * 8) = (u32x4){0u, 0u, 0u, 0u};
        for (int idx = gt; idx < 2048 * 256 / 4; idx += ngt) { const f32x4 v = *(const f32x4*)(a.in[2] + (size_t)idx * 4); u32x2 w; w.x = cvt_pk_bf16(v[0], v[1]); w.y = cvt_pk_bf16(v[2], v[3]);
            *(u32x2*)(KVA + (size_t)NTOK * 256 + (size_t)idx * 4) = w; }
        for (int idx = gt; idx < 2048 * 32 / 4; idx += ngt) { const f32x4 v = *(const f32x4*)(a.in[3] + (size_t)idx * 4); const int j = idx >> 3, c4 = idx & 7; u32x2 w; w.x = cvt_pk_bf16(v[0], v[1]); w.y = cvt_pk_bf16(v[2], v[3]);
            *(u32x2*)(KR + (size_t)(NCTX + 1536 * (j >> 9) + (j & 511)) * 32 + c4 * 4) = w; }
        if (bx == G - 1) { const int p = tid >> 3, f = tid & 7; const float inv = exp2f(-(float)f * 0.125f * 13.287712379549449f); const float ang = (float)p * inv; ROPE[tid * 2] = cosf(ang); ROPE[tid * 2 + 1] = sinf(ang); }
    }
    SEAM(0);
    if (IN(1)) norm_rows<false>(xp, xs - (size_t)NCTX * D, a.in[8], MODS, 0, 1024, H, nullptr, gw, ngw, lane);
    SEAM(1);
    if (IN(2)) {
        pg8::Gemm g{H, WT1, NTOK, INP, D}; pg8::StaticOrder S; S.init(NTOK, INP, G, bx);
        Epi1 E{QLAT, KVA, KVRAW, GVT, GU, KR, SSQ1, out_krope, a.in[10], a.in[12], ROPE};
        pg8::gemm_phase<Epi1, pg8::StaticOrder, true, true>(lds, g, S, E);
    }
    SEAM(2);
    if (IN(3)) {
        if (G >= 256) {
            if (bx < 96) { pg8::Gemm g{QLAT, WTQ, NTOK, 768, 384}; pg8::StaticOrder S; S.init(NTOK, 768, 96, bx); Epi2 E{Qb, SSQ1, ROPE};
                pg8::gemm_phase<Epi2, pg8::StaticOrder, true, true>(lds, g, S, E); }
            else if (bx < 256) { pg8::Gemm g{KVA, WTKV, NKEY, 1024, 256}; pg8::StaticOrder S; S.init(NKEY, 1024, 160, bx - 96); Epi3 E{KN, VT, SSQ1};
                pg8::gemm_phase<Epi3, pg8::StaticOrder, true, true>(lds, g, S, E); }
        } else {
            { pg8::Gemm g{QLAT, WTQ, NTOK, 768, 384}; pg8::StaticOrder S; S.init(NTOK, 768, G, bx); Epi2 E{Qb, SSQ1, ROPE};
                pg8::gemm_phase<Epi2, pg8::StaticOrder, true, true>(lds, g, S, E); }
            { pg8::Gemm g{KVA, WTKV, NKEY, 1024, 256}; pg8::StaticOrder S; S.init(NKEY, 1024, G, bx); Epi3 E{KN, VT, SSQ1};
                pg8::gemm_phase<Epi3, pg8::StaticOrder, true, true>(lds, g, S, E); }
        }
    }
    SEAM(3);
    if (IN(4)) {
        for (int u = vcu; u < 512; u += G) {
            if (u < 256) { const int seq = u >> 6, head = (u >> 3) & 7, qb = u & 7; attn_unit(lds, Qb, KN, KR, VT, AO, SSQA, NCTX + seq * 1024 + qb * 128, head, NCTX + 1536 * seq, 1536); }
            else { const int v = u - 256, seq = v >> 4, head = (v >> 1) & 7, qb = v & 1; attn_unit(lds, Qb, KN, KR, VT, AO, SSQA, seq * 256 + qb * 128, head, seq * 256, 256); }
        }
    }
    SEAM(4);
    if (IN(5)) {
        const int nsp = (G > 64) ? 64 : 0;
        if (nsp) { if (bx < 64) spatial_unit(lds, bx, GVT, GU, SSQ1, a.in[15], a.in[16], a.in[14], a.in[18], MIX); }
        else for (int c = bx; c < 64; c += G) spatial_unit(lds, c, GVT, GU, SSQ1, a.in[15], a.in[16], a.in[14], a.in[18], MIX);
        if (!nsp || bx >= 64) {
            const int w0 = nsp ? (bx - 64) * 8 + wave : gw, nw = nsp ? (G - 64) * 8 : ngw;
            for (int row = w0; row < NTOK; row += nw) {
                const f32x4 p0 = *(const f32x4*)(SSQA + (size_t)row * 8), p1 = *(const f32x4*)(SSQA + (size_t)row * 8 + 4);
                const float rs = 1.0f / sqrtf((((p0[0] + p0[1]) + (p0[2] + p0[3])) + ((p1[0] + p1[1]) + (p1[2] + p1[3]))) * (1.f / 512.f) + EPS);
#pragma unroll
                for (int j = 0; j < 2; ++j) { const int col = 4 * lane + 256 * j; const f32x4 v = *(const f32x4*)(AO + (size_t)row * 512 + col) * rs * *(const f32x4*)(a.in[17] + col);
                    u32x2 w; w.x = cvt_pk_bf16(v[0], v[1]); w.y = cvt_pk_bf16(v[2], v[3]); *(u32x2*)(MIX + (size_t)row * D + col) = w; }
            }
            for (int row = w0; row < NCTX; row += nw) {
                const f32x4 p0 = *(const f32x4*)(SSQ1 + (size_t)row * SSQS + 12), p1 = *(const f32x4*)(SSQ1 + (size_t)row * SSQS + 16);
                const float rs = 1.0f / sqrtf((((p0[0] + p0[1]) + (p0[2] + p0[3])) + ((p1[0] + p1[1]) + (p1[2] + p1[3]))) * (1.f / 256.f) + EPS);
                const int col = 4 * lane;
                *(f32x4*)(out_ckv + (size_t)row * 256 + col) = *(const f32x4*)(KVRAW + (size_t)row * 256 + col) * rs * *(const f32x4*)(a.in[12] + col);
            }
        }
    }
    SEAM(5);
    if (IN(6)) {
        pg8::Gemm g{MIX, WTO, NTOK, D, D}; pg8::StaticOrder S; S.init(NTOK, D, G, bx);
        EpiRes E{xp, xs - (size_t)NCTX * D, X1, MODS + 2048};
        pg8::gemm_phase<EpiRes, pg8::StaticOrder, true, true>(lds, g, S, E);
    }
    SEAM(6);
    if (IN(7)) norm_rows<false>(X1, X1, a.in[20], MODS, 3072, 4096, H, nullptr, gw, ngw, lane);
    SEAM(7);
    if (IN(8)) {
        pg8::Gemm g{H, WTUP, NTOK, DFF2, D}; pg8::StaticOrder S; S.init(NTOK, DFF2, G, bx);
        EpiPlain E{AUP, DFF2};
        pg8::gemm_phase<EpiPlain, pg8::StaticOrder, true, true>(lds, g, S, E);
    }
    SEAM(8);
    if (IN(9)) {
        const float* cw = a.in[22]; const float* cbias = a.in[23];
        for (int task = bx * 512 + tid; task < 512 * 352; task += G * 512) {
            const int rg = task / 352, oc = task % 352, c0 = oc * 8, r0 = rg * 16;
            const int slen = (r0 < NCTX) ? 256 : 1024;
            float wg[3][8], wv[3][8], bg[8], bv[8];
#pragma unroll
            for (int k = 0; k < 3; ++k) { const f32x4 x0 = *(const f32x4*)(cw + k * DFF2 + c0), x1 = *(const f32x4*)(cw + k * DFF2 + c0 + 4), y0 = *(const f32x4*)(cw + k * DFF2 + DFF + c0), y1 = *(const f32x4*)(cw + k * DFF2 + DFF + c0 + 4);
#pragma unroll
                for (int e = 0; e < 4; ++e) { wg[k][e] = x0[e]; wg[k][e + 4] = x1[e]; wv[k][e] = y0[e]; wv[k][e + 4] = y1[e]; } }
            { const f32x4 x0 = *(const f32x4*)(cbias + c0), x1 = *(const f32x4*)(cbias + c0 + 4), y0 = *(const f32x4*)(cbias + DFF + c0), y1 = *(const f32x4*)(cbias + DFF + c0 + 4);
#pragma unroll
              for (int e = 0; e < 4; ++e) { bg[e] = x0[e]; bg[e + 4] = x1[e]; bv[e] = y0[e]; bv[e + 4] = y1[e]; } }
            u32x4 pg_, pv_, cg_, cv_, ng_, nv_;
            const u32x4 z4 = (u32x4){0u, 0u, 0u, 0u};
            const bf16_t* ap = AUP + (size_t)r0 * DFF2 + c0;
            if ((r0 & (slen - 1)) == 0) { pg_ = z4; pv_ = z4; } else { pg_ = *(const u32x4*)(ap - DFF2); pv_ = *(const u32x4*)(ap - DFF2 + DFF); }
            cg_ = *(const u32x4*)ap; cv_ = *(const u32x4*)(ap + DFF);
#pragma unroll 4
            for (int rr = 0; rr < 16; ++rr) {
                const int row = r0 + rr;
                if ((row & (slen - 1)) == slen - 1) { ng_ = z4; nv_ = z4; } else { ng_ = *(const u32x4*)(ap + (size_t)(rr + 1) * DFF2); nv_ = *(const u32x4*)(ap + (size_t)(rr + 1) * DFF2 + DFF); }
                unsigned ow[4];
#pragma unroll
                for (int e2 = 0; e2 < 4; ++e2) {
                    const int e = 2 * e2;
                    const float g_lo = bg[e] + wg[0][e] * BFLO(pg_[e2]) + wg[1][e] * BFLO(cg_[e2]) + wg[2][e] * BFLO(ng_[e2]);
                    const float g_hi = bg[e + 1] + wg[0][e + 1] * BFHI(pg_[e2]) + wg[1][e + 1] * BFHI(cg_[e2]) + wg[2][e + 1] * BFHI(ng_[e2]);
                    const float v_lo = bv[e] + wv[0][e] * BFLO(pv_[e2]) + wv[1][e] * BFLO(cv_[e2]) + wv[2][e] * BFLO(nv_[e2]);
                    const float v_hi = bv[e + 1] + wv[0][e + 1] * BFHI(pv_[e2]) + wv[1][e + 1] * BFHI(cv_[e2]) + wv[2][e + 1] * BFHI(nv_[e2]);
                    ow[e2] = cvt_pk_bf16(g_lo / (1.f + __expf(-g_lo)) * v_lo, g_hi / (1.f + __expf(-g_hi)) * v_hi);
                }
                *(u32x4*)(Gb + (size_t)row * DFF + c0) = (u32x4){ow[0], ow[1], ow[2], ow[3]};
                pg_ = cg_; pv_ = cv_; cg_ = ng_; cv_ = nv_;
            }
        }
    }
    SEAM(9);
    if (IN(10)) {
        pg8::Gemm g{Gb, WTDN, NTOK, D, DFF}; pg8::StaticOrder S; S.init(NTOK, D, G, bx);
        EpiRes E{X1, X1, out_y, MODS + 5120};
        pg8::gemm_phase<EpiRes, pg8::StaticOrder, true, true>(lds, g, S, E);
    }
    SEAM(10);
    if (IN(11)) norm_rows<true>(out_y, out_y, a.in[25], nullptr, 0, 0, nullptr, out_y, gw, ngw, lane);
#undef IN
#undef SEAM
}

extern "C" void kernel_launch(void* const* d_in, const int* in_sizes, int n_in, void* d_out, int out_size, void* d_ws, size_t ws_size, hipStream_t stream) {
    static int grid = 0;
    if (grid == 0) {
        if (n_in != 26 || ws_size < WS_END) { fprintf(stderr, "kernel_launch: unexpected n_in %d / ws %zu\n", n_in, ws_size); grid = -1; return; }
        int dev = 0, cus = 0, per_cu = 0;
        hipGetDevice(&dev); hipDeviceGetAttribute(&cus, hipDeviceAttributeMultiprocessorCount, dev);
        if (hipFuncSetAttribute((const void*)mk_fwd, hipFuncAttributeMaxDynamicSharedMemorySize, LDS_BYTES) != hipSuccess) { fprintf(stderr, "kernel_launch: hipFuncSetAttribute failed\n"); grid = -1; return; }
        if (hipOccupancyMaxActiveBlocksPerMultiprocessor(&per_cu, (const void*)mk_fwd, 512, LDS_BYTES) != hipSuccess || per_cu < 1) { fprintf(stderr, "kernel_launch: occupancy query says %d\n", per_cu); per_cu = 1; }
        (void)hipGetLastError();
        grid = cus * 1;
        if (grid > 256) grid = 256;
    }
    if (grid < 0) return;
    Args a{};
    for (int i = 0; i < 26; ++i) a.in[i] = (const float*)d_in[i];
    a.out = (float*)d_out; a.ws = (unsigned char*)d_ws;
#if MK_ONE_LAUNCH
    a.ph_lo = 0; a.ph_hi = NPH;
    void* args[] = {&a};
    hipError_t e = hipLaunchCooperativeKernel((const void*)mk_fwd, dim3(grid), dim3(512), args, LDS_BYTES, stream);
    if (e != hipSuccess) fprintf(stderr, "cooperative launch failed: %s (grid %d)\n", hipGetErrorString(e), grid);
#else
    for (int p = 0; p < NPH; ++p) { a.ph_lo = p; a.ph_hi = p + 1; hipLaunchKernelGGL(mk_fwd, dim3(grid), dim3(512), LDS_BYTES, stream, a); }
#endif
}
```

```cpp
#include <hip/hip_runtime.h>
#include <hip/hip_cooperative_groups.h>
#include <cstdio>
#include <cstdint>
namespace cg = cooperative_groups;
#ifndef PG8_TS
#define PG8_TS(id, begin) do { } while (0)
#endif
namespace pg8 {
#define PG8_LAS __attribute__((address_space(3)))
typedef unsigned short bf16_t;
typedef short bf16x8 __attribute__((ext_vector_type(8)));
typedef float f32x4 __attribute__((ext_vector_type(4)));
typedef unsigned u32x4 __attribute__((ext_vector_type(4)));
constexpr int BM = 256, BK = 64, HALF = 128, HTB = HALF * BK * 2  , STAGE_BYTES = 8 * HTB, NXCD = 8, WGM = 4;

__host__ __device__ __forceinline__ int lds_byte(int r, int c) { const int st = (r >> 4) * 2 + (c >> 5), rr = r & 15, cc = c & 31, ob = rr * 64 + cc * 2; return st * 1024 + (ob ^ (((ob >> 9) & 1) << 5)); }
__host__ __device__ __forceinline__ void stage_rc(int b, int& R, int& C) { const int st = b / 1024, sb = b % 1024, swz = sb ^ (((sb >> 9) & 1) << 5); R = (st >> 1) * 16 + swz / 64; C = (st & 1) * 32 + (swz % 64) / 2; }
__host__ __device__ __forceinline__ int perm32(int rho) { const int n = rho >> 4, i = rho & 15; return 8 * (i >> 2) + 4 * n + (i & 3); }

struct Unit { int pm, pn, koff; };
struct Gemm { const bf16_t* A; const bf16_t* Bt; int M, N, K, lda, ldb; };

struct StaticOrder {
    int nM, nN, nwg, G, c;
    __host__ __device__ void init(int M, int N, int G_, int c_) { nM = M / BM; nN = N / BM; nwg = nM * nN; G = G_; c = c_; }
    __host__ __device__ bool next(int i, Unit& u) const {
        const long L = (long)i * G + c; if (L >= nwg) return false;
        int wgid = (int)L; { const int q = nwg / NXCD, r = nwg % NXCD, xcd = wgid % NXCD, off = wgid / NXCD; wgid = (xcd < r ? xcd * (q + 1) : r * (q + 1) + (xcd - r) * q) + off; }
        const int nig = WGM * nN, gid = wgid / nig, fm = gid * WGM, gsz = (nM - fm) < WGM ? (nM - fm) : WGM;
        u.pm = fm + ((wgid % nig) % gsz); u.pn = (wgid % nig) / gsz; u.koff = 0; return true;
    }
    __device__ __forceinline__ void a_ready(const Unit&) const {}
    __device__ __forceinline__ void done(const Unit&) const {}
};

__device__ __forceinline__ unsigned cvt_pk_bf16(float lo, float hi) { unsigned r; asm volatile("v_cvt_pk_bf16_f32 %0, %1, %2" : "=v"(r) : "v"(lo), "v"(hi)); return r; }
typedef float f32x2 __attribute__((ext_vector_type(2)));
__device__ __forceinline__ f32x2 gelu_pk(f32x2 v) {
    const f32x2 av = __builtin_elementwise_abs(v), d = av * 0.2316418882f + 1.0f;
    f32x2 t; t.x = __builtin_amdgcn_rcpf(d.x); t.y = __builtin_amdgcn_rcpf(d.y);
    f32x2 q = t * 0.5307027145f + (-0.7265760135f); q = q * t + 0.7107068705f; q = q * t + (-0.142248368f); q = q * t + 0.127414796f; q = q * t;
    const f32x2 s = (v * v) * (-0.72134752044f);
    f32x2 e; e.x = __builtin_amdgcn_exp2f(s.x); e.y = __builtin_amdgcn_exp2f(s.y);
    const f32x2 m = v * (q * e), r = v - m;
    f32x2 o; o.x = v.x < 0.f ? m.x : r.x; o.y = v.y < 0.f ? m.y : r.y; return o;
}
template <class Epi, class Sched, bool ALIGN_EPI = false, bool SP2 = false>
__device__ __forceinline__ void gemm_phase(PG8_LAS unsigned char* lds, const Gemm g, const Sched& S, const Epi& E) {
    const int tid = threadIdx.x, wid = __builtin_amdgcn_readfirstlane(tid >> 6), lane = tid & 63, wr = wid >> 2, wc = wid & 3, fr = lane & 15, fq = lane >> 4;
    const int K = g.K, nt = K / BK;
    unsigned voffA[2], voffB[2];
#pragma unroll
    for (int i = 0; i < 2; ++i) { int R, C; stage_rc(tid * 16 + i * 8192, R, C); const int Rb = Epi::PERM ? ((R & ~31) + perm32(R & 31)) : R;
        voffA[i] = (unsigned)(R * g.lda + C) * 2u; voffB[i] = (unsigned)(Rb * g.ldb + C) * 2u; }
    const size_t kstep = (size_t)(BK * 2);
    const size_t hstepA = (size_t)HALF * g.lda * 2, hstepB = (size_t)HALF * g.ldb * 2;
    const size_t tstepA = 2 * hstepA, tstepB = 2 * hstepB;
    const unsigned ldsw = (unsigned)wid * 1024u;
    const int aoff = lds_byte(wr * 64 + fr, fq * 8), boff = lds_byte(wc * 32 + fr, fq * 8);
#define PG8_SA(b, h) (((b) * 2 + (h)) * HTB)
#define PG8_SB(b, h) ((4 + (b) * 2 + (h)) * HTB)
#define PG8_STAGE(bufoff, gbase, voff) do { _Pragma("unroll") for (int _i = 0; _i < 2; ++_i) \
        __builtin_amdgcn_global_load_lds((const unsigned*)((const char*)(gbase) + (voff)[_i]), (PG8_LAS unsigned*)(lds + (bufoff) + ldsw + _i * 8192), 16, 0, 0); } while (0)
#define PG8_LDA(dst, b, h) do { _Pragma("unroll") for (int m = 0; m < 4; ++m) _Pragma("unroll") for (int k = 0; k < 2; ++k) dst[m][k] = *(const PG8_LAS bf16x8*)(lds + PG8_SA(b, h) + aoff + m * 2048 + k * 1024); } while (0)
#define PG8_LDB(dst, b, h) do { _Pragma("unroll") for (int n = 0; n < 2; ++n) _Pragma("unroll") for (int k = 0; k < 2; ++k) dst[n][k] = *(const PG8_LAS bf16x8*)(lds + PG8_SB(b, h) + boff + n * 2048 + k * 1024); } while (0)
#define PG8_MMA(ai, bj, At, Bt) do { __builtin_amdgcn_s_setprio(1); _Pragma("unroll") for (int m = 0; m < 4; ++m) _Pragma("unroll") for (int n = 0; n < 2; ++n) _Pragma("unroll") for (int k = 0; k < 2; ++k) \
        acc[ai][bj][m][n] = __builtin_amdgcn_mfma_f32_16x16x32_bf16(Bt[n][k], At[m][k], acc[ai][bj][m][n], 0, 0, 0); __builtin_amdgcn_s_setprio(0); } while (0)
#define PG8_WAIT_V(n) asm volatile("s_waitcnt vmcnt(" #n ")" ::: "memory")
#define PG8_WAIT_L(n) asm volatile("s_waitcnt lgkmcnt(" #n ")" ::: "memory")
#define PG8_BAR __builtin_amdgcn_s_barrier()
#define PG8_SCHED __builtin_amdgcn_sched_barrier(0)
    Unit cur, nxt; int ui = 0;
    if (!S.next(0, cur)) return;
    f32x4 acc[2][2][4][2];
#pragma unroll
    for (int a = 0; a < 2; ++a)
#pragma unroll
        for (int b = 0; b < 2; ++b)
#pragma unroll
            for (int m = 0; m < 4; ++m)
#pragma unroll
                for (int n = 0; n < 2; ++n) acc[a][b][m][n] = (f32x4){0.f, 0.f, 0.f, 0.f};
    bf16x8 At[4][2], B0[2][2], B1[2][2];
    const char* cA = (const char*)g.A + (size_t)cur.pm * tstepA + (size_t)cur.koff * 2; const char* cB = (const char*)g.Bt + (size_t)cur.pn * tstepB + (size_t)cur.koff * 2;
    S.a_ready(cur);
    if constexpr (SP2) {
        PG8_STAGE(PG8_SB(0, 0), cB, voffB); PG8_STAGE(PG8_SB(0, 1), cB + hstepB, voffB); PG8_STAGE(PG8_SA(0, 0), cA, voffA); PG8_STAGE(PG8_SA(0, 1), cA + hstepA, voffA);
        if (wr == 1) PG8_BAR;
        PG8_WAIT_V(2); PG8_BAR;
        PG8_STAGE(PG8_SB(1, 0), cB + kstep, voffB); PG8_STAGE(PG8_SA(1, 0), cA + kstep, voffA); PG8_STAGE(PG8_SB(1, 1), cB + hstepB + kstep, voffB);
        PG8_WAIT_V(6); PG8_BAR;
    } else {
        PG8_STAGE(PG8_SB(0, 0), cB, voffB); PG8_STAGE(PG8_SA(0, 0), cA, voffA); PG8_STAGE(PG8_SB(0, 1), cB + hstepB, voffB); PG8_STAGE(PG8_SA(0, 1), cA + hstepA, voffA);
        if (wr == 1) PG8_BAR;
        PG8_WAIT_V(4); PG8_BAR;
        PG8_STAGE(PG8_SB(1, 0), cB + kstep, voffB); PG8_STAGE(PG8_SA(1, 0), cA + kstep, voffA); PG8_STAGE(PG8_SB(1, 1), cB + hstepB + kstep, voffB);
        PG8_WAIT_V(6); PG8_BAR;
    }
    for (;;) {
        const bool has_next = S.next(ui + 1, nxt);
        const char* nA = has_next ? (const char*)g.A + (size_t)nxt.pm * tstepA + (size_t)nxt.koff * 2 : cA; const char* nB = has_next ? (const char*)g.Bt + (size_t)nxt.pn * tstepB + (size_t)nxt.koff * 2 : cB;
#pragma clang loop unroll(disable)
        for (int t = 0; t < nt; t += 2) {
            const bool last = (t == nt - 2);
            const char* a1 = cA + (size_t)(t + 1) * kstep;
            const char* a2 = last ? nA : cA + (size_t)(t + 2) * kstep; const char* b2 = last ? nB : cB + (size_t)(t + 2) * kstep;
            const char* a3 = a2 + kstep; const char* b3 = b2 + kstep;
            if (last && has_next) S.a_ready(nxt);
            if constexpr (SP2) {
            PG8_LDB(B0, 0, 0); PG8_LDB(B1, 0, 1); PG8_SCHED; PG8_LDA(At, 0, 0); PG8_STAGE(PG8_SA(1, 1), a1 + hstepA, voffA);
            PG8_WAIT_V(8); PG8_WAIT_L(0); PG8_BAR; PG8_MMA(0, 0, At, B0); PG8_MMA(0, 1, At, B1); PG8_BAR; PG8_SCHED;
            PG8_LDA(At, 0, 1); PG8_STAGE(PG8_SB(0, 0), b2, voffB); PG8_STAGE(PG8_SB(0, 1), b2 + hstepB, voffB); PG8_STAGE(PG8_SA(0, 0), a2, voffA);
            PG8_WAIT_V(8); PG8_WAIT_L(0); PG8_BAR; PG8_MMA(1, 0, At, B0); PG8_MMA(1, 1, At, B1); PG8_BAR; PG8_SCHED;
            PG8_LDB(B0, 1, 0); PG8_LDB(B1, 1, 1); PG8_SCHED; PG8_LDA(At, 1, 0); PG8_STAGE(PG8_SA(0, 1), a2 + hstepA, voffA);
            PG8_WAIT_V(8); PG8_WAIT_L(0); PG8_BAR; PG8_MMA(0, 0, At, B0); PG8_MMA(0, 1, At, B1); PG8_BAR; PG8_SCHED;
            PG8_LDA(At, 1, 1); PG8_STAGE(PG8_SB(1, 0), b3, voffB); PG8_STAGE(PG8_SB(1, 1), b3 + hstepB, voffB); PG8_STAGE(PG8_SA(1, 0), a3, voffA);
            PG8_WAIT_V(8); PG8_WAIT_L(0); PG8_BAR; PG8_MMA(1, 0, At, B0); PG8_MMA(1, 1, At, B1); PG8_BAR; PG8_SCHED;
            } else {
            PG8_LDB(B0, 0, 0); PG8_SCHED; PG8_LDA(At, 0, 0); PG8_STAGE(PG8_SA(1, 1), a1 + hstepA, voffA);
            PG8_WAIT_L(8); PG8_BAR; PG8_WAIT_L(0); PG8_MMA(0, 0, At, B0); PG8_BAR; PG8_SCHED;
            PG8_LDB(B1, 0, 1); PG8_STAGE(PG8_SB(0, 0), b2, voffB);
            PG8_BAR; PG8_WAIT_L(0); PG8_MMA(0, 1, At, B1); PG8_BAR;
            PG8_LDA(At, 0, 1); PG8_STAGE(PG8_SA(0, 0), a2, voffA);
            PG8_BAR; PG8_WAIT_L(0); PG8_MMA(1, 0, At, B0); PG8_BAR; PG8_SCHED;
            PG8_STAGE(PG8_SB(0, 1), b2 + hstepB, voffB);
            PG8_WAIT_V(6); PG8_BAR; PG8_MMA(1, 1, At, B1); PG8_BAR;
            PG8_LDB(B0, 1, 0); PG8_SCHED; PG8_LDA(At, 1, 0); PG8_STAGE(PG8_SA(0, 1), a2 + hstepA, voffA);
            PG8_WAIT_L(8); PG8_BAR; PG8_WAIT_L(0); PG8_MMA(0, 0, At, B0); PG8_BAR; PG8_SCHED;
            PG8_LDB(B1, 1, 1); PG8_STAGE(PG8_SB(1, 0), b3, voffB);
            PG8_BAR; PG8_WAIT_L(0); PG8_MMA(0, 1, At, B1); PG8_BAR;
            PG8_LDA(At, 1, 1); PG8_STAGE(PG8_SA(1, 0), a3, voffA);
            PG8_BAR; PG8_WAIT_L(0); PG8_MMA(1, 0, At, B0); PG8_BAR; PG8_SCHED;
            PG8_STAGE(PG8_SB(1, 1), b3 + hstepB, voffB);
            PG8_WAIT_V(6); PG8_BAR; PG8_MMA(1, 1, At, B1); PG8_BAR;
            }
        }
        if constexpr (ALIGN_EPI) { if (wr == 0) PG8_BAR; }
        if constexpr (!Epi::AFTER_DRAIN) { E(acc, cur, wr, wc, fr, fq); S.done(cur); }
        if (!has_next) break;
#pragma unroll
        for (int a = 0; a < 2; ++a)
#pragma unroll
            for (int b = 0; b < 2; ++b)
#pragma unroll
                for (int m = 0; m < 4; ++m)
#pragma unroll
                    for (int n = 0; n < 2; ++n) acc[a][b][m][n] = (f32x4){0.f, 0.f, 0.f, 0.f};
        cur = nxt; cA = nA; cB = nB; ++ui;
        if constexpr (ALIGN_EPI) { if (wr == 1) PG8_BAR; }
    }
    PG8_WAIT_V(0);
    if constexpr (!ALIGN_EPI) { if (wr == 0) PG8_BAR; }
    PG8_BAR;
    if constexpr (Epi::AFTER_DRAIN) { E.fused(acc, cur, wr, wc, fr, fq, lds, wid, lane); S.done(cur); }
#undef PG8_SA
#undef PG8_SB
#undef PG8_STAGE
#undef PG8_LDA
#undef PG8_LDB
#undef PG8_MMA
#undef PG8_WAIT_V
#undef PG8_WAIT_L
#undef PG8_BAR
#undef PG8_SCHED
}
}

using pg8::bf16_t; using pg8::bf16x8; using pg8::f32x4; using pg8::u32x4; using pg8::Unit; using pg8::cvt_pk_bf16; using pg8::gelu_pk; using pg8::f32x2;
#define LAS __attribute__((address_space(3)))
typedef float f32x16 __attribute__((ext_vector_type(16)));
typedef unsigned u32x2 __attribute__((ext_vector_type(2)));

#ifndef MK_REP
#define MK_REP 0
#endif
#ifndef MK_REPN
#define MK_REPN 1
#endif
#ifndef DUPP0
#define DUPP0 1
#endif
#ifndef DUPP1
#define DUPP1 1
#endif
#ifndef DUPP2
#define DUPP2 1
#endif
#ifndef DUPP3
#define DUPP3 1
#endif
#ifndef DUPP4
#define DUPP4 1
#endif
#ifndef DUPP5
#define DUPP5 1
#endif
#ifndef DUPP6
#define DUPP6 1
#endif
#ifndef DUPP7
#define DUPP7 1
#endif
#ifndef DUPP8
#define DUPP8 1
#endif
#ifndef DUPP9
#define DUPP9 1
#endif
#ifndef DUPP10
#define DUPP10 1
#endif
#ifndef DUP_P0C
#define DUP_P0C 1
#endif
#ifndef DUP_ATT
#define DUP_ATT 1
#endif
#ifndef DUP_SPA
#define DUP_SPA 1
#endif
#ifndef DUP_E1V
#define DUP_E1V 1
#endif
#ifndef DUP_P0T
#define DUP_P0T 1
#endif
#ifndef DUP_P0G
#define DUP_P0G 1
#endif
#ifndef DUP_EC
#define DUP_EC 1
#endif
#ifndef DUP_E1U
#define DUP_E1U 1
#endif
#ifndef MK_ONE_LAUNCH
#define MK_ONE_LAUNCH 1
#endif

constexpr int D = 1024, NTOK = 8192, NCTX = 4096, NKEY = 10240, INW = 1696, INP = 1792, DFF = 2816, DFF2 = 5632;
constexpr int SSQS = 36;
constexpr float EPS = 1e-6f;
constexpr float QSCALE = 0.10206207261596575f * 1.4426950408889634f;
constexpr int NPH = 11;
constexpr size_t MiB = (size_t)1 << 20;
constexpr size_t WS_WT1 = 0, WS_WTQ = 4 * MiB, WS_WTKV = 5 * MiB, WS_WTO = 6 * MiB, WS_WTUP = 8 * MiB, WS_WTDN = 19 * MiB, WS_MODS = 25 * MiB,
                 WS_SSQ1 = 26 * MiB, WS_ROPE = 28 * MiB, WS_SSQA = 30 * MiB, WS_KR = 31 * MiB, WS_KVRAW = 32 * MiB, WS_H = 36 * MiB,
                 WS_QLAT = 64 * MiB, WS_KVA = 70 * MiB, WS_GVT = 75 * MiB, WS_GU = 83 * MiB, WS_Q = 91 * MiB, WS_KN = 103 * MiB, WS_VT = 113 * MiB,
                 WS_SSQG = 29 * MiB, WS_CTL = 52 * MiB, WS_MIX = 139 * MiB, WS_AUP = 64 * MiB, WS_X1 = 160 * MiB, WS_G = 192 * MiB, WS_PA = 192 * MiB, WS_PG = 208 * MiB, WS_P0 = 64 * MiB, WS_P1 = 80 * MiB, WS_SB = 128 * MiB, WS_END = 236 * MiB;
constexpr int CTL_BYTES = 16384;
constexpr int LDS_BYTES = 147456;

struct Args { const float* in[26]; float* out; unsigned char* ws; int ph_lo, ph_hi; };

__device__ __forceinline__ unsigned f2bf(float f) { unsigned u = __float_as_uint(f); return (u + 0x7fffu + ((u >> 16) & 1u)) >> 16; }
__device__ __forceinline__ float bf2f(unsigned short b) { return __uint_as_float((unsigned)b << 16); }
__device__ __forceinline__ float wave_sum(float v) {
#pragma unroll
    for (int o = 1; o < 64; o <<= 1) v += __shfl_xor(v, o);
    return v;
}
__device__ __forceinline__ u32x4 pack8(f32x4 a, f32x4 b) { u32x4 w; w.x = cvt_pk_bf16(a[0], a[1]); w.y = cvt_pk_bf16(a[2], a[3]); w.z = cvt_pk_bf16(b[0], b[1]); w.w = cvt_pk_bf16(b[2], b[3]); return w; }
__device__ __forceinline__ f32x4 gelu4(f32x4 v) { f32x2 a = gelu_pk((f32x2){v[0], v[1]}), b = gelu_pk((f32x2){v[2], v[3]}); return (f32x4){a.x, a.y, b.x, b.y}; }
__device__ __forceinline__ float dot4(f32x4 a) { return (a[0] * a[0] + a[1] * a[1]) + (a[2] * a[2] + a[3] * a[3]); }
__device__ __forceinline__ int mod_of_row(int row) { return row < NCTX ? 0 : 1 + ((row - NCTX) >> 10); }
__device__ __forceinline__ void rope8(f32x4& v0, f32x4& v1, float pos, int fq) {
    const float sg = (fq & 1) ? 1.f : -1.f;
    const float kf[8] = {0.15915494309189535f, 0.05032921210448704f, 0.015915494309189534f, 0.005032921210448704f, 0.0015915494309189536f, 0.0005032921210448704f, 0.00015915494309189535f, 0.00005032921210448704f};
#pragma unroll
    for (int e = 0; e < 4; ++e) {
        const float o0 = __shfl_xor(v0[e], 16), o1 = __shfl_xor(v1[e], 16);
        const float r0 = pos * kf[e], r1 = pos * kf[e + 4];
        const float c0 = __builtin_amdgcn_cosf(r0), s0 = __builtin_amdgcn_sinf(r0), c1 = __builtin_amdgcn_cosf(r1), s1 = __builtin_amdgcn_sinf(r1);
        v0[e] = v0[e] * c0 + sg * o0 * s0; v1[e] = v1[e] * c1 + sg * o1 * s1;
    }
}

struct Epi1 {
    static constexpr bool PERM = true, AFTER_DRAIN = false;
    bf16_t* qlat; bf16_t* kva; float* kvraw; bf16_t* gvt; bf16_t* gu; bf16_t* kr; float* ssq; float* out_krope; const float* qg; const float* kvg; const float* rope;
    __device__ __forceinline__ void operator()(const f32x4 (&acc)[2][2][4][2], const Unit& u, int wr, int wc, int fr, int fq) const {
        const int cl = wc * 32 + fq * 8;
#pragma unroll
        for (int bj = 0; bj < 2; ++bj) {
            const int hc = u.pn * 2 + bj;
            if (hc < 5) {
                const bool isq = hc < 3;
                const float* g = isq ? qg + hc * 128 + cl : kvg + (hc - 3) * 128 + cl;
                const f32x4 g0 = *(const f32x4*)g, g1 = *(const f32x4*)(g + 4);
#pragma unroll
                for (int ai = 0; ai < 2; ++ai)
#pragma unroll
                    for (int m = 0; m < 4; ++m) {
                        const int row = u.pm * 256 + ai * 128 + wr * 64 + m * 16 + fr;
                        const f32x4 v0 = acc[ai][bj][m][0], v1 = acc[ai][bj][m][1];
                        float s = dot4(v0) + dot4(v1); s += __shfl_xor(s, 16); s += __shfl_xor(s, 32);
                        if (fq == 0) ssq[(size_t)row * SSQS + hc * 4 + wc] = s;
                        if (!isq && row < NCTX) { float* p = kvraw + (size_t)row * 256 + (hc - 3) * 128 + cl; *(f32x4*)p = v0; *(f32x4*)(p + 4) = v1; }
                        const u32x4 w = pack8(v0 * g0, v1 * g1);
                        bf16_t* dst = isq ? qlat + (size_t)row * 384 + hc * 128 + cl : kva + (size_t)row * 256 + (hc - 3) * 128 + cl;
                        *(u32x4*)dst = w;
                    }
            } else if (hc < 13 && ((hc - 5) & 1) == 0) {
                const int gi = (hc - 5) >> 1;
                for (int dup = 0; dup < DUP_E1V; ++dup)
#pragma unroll
                for (int ai = 0; ai < 2; ++ai)
#pragma unroll
                    for (int m = 0; m < 4; ++m) {
                        const int row = u.pm * 256 + ai * 128 + wr * 64 + m * 16 + fr;
                        const f32x4 v0 = gelu4(acc[ai][bj][m][0]), v1 = gelu4(acc[ai][bj][m][1]);
                        float s = dot4(v0) + dot4(v1); s += __shfl_xor(s, 16); s += __shfl_xor(s, 32);
                        if (fq == 0) ssq[(size_t)row * SSQS + (5 + gi) * 4 + wc] = s;
                        bf16_t* dst = gvt + (size_t)(gi * 128 + cl) * NTOK + row;
#pragma unroll
                        for (int e = 0; e < 4; ++e) { dst[(size_t)e * NTOK] = (bf16_t)f2bf(v0[e]); dst[(size_t)(e + 4) * NTOK] = (bf16_t)f2bf(v1[e]); }
                    }
            } else if (hc < 13) {
                for (int dup = 0; dup < DUP_E1U; ++dup)
#pragma unroll
                for (int ai = 0; ai < 2; ++ai)
#pragma unroll
                    for (int m = 0; m < 4; ++m) {
                        const int row = u.pm * 256 + ai * 128 + wr * 64 + m * 16 + fr;
                        const f32x4 v0 = gelu4(acc[ai][bj][m][0]), v1 = gelu4(acc[ai][bj][m][1]);
                        *(u32x4*)(gu + (size_t)row * 512 + ((hc - 5) >> 1) * 128 + cl) = pack8(v0, v1);
                    }
            } else if (wc == 0) {
                const bool lat = u.pm >= 16;
#pragma unroll
                for (int ai = 0; ai < 2; ++ai)
#pragma unroll
                    for (int m = 0; m < 4; ++m) {
                        const int row = u.pm * 256 + ai * 128 + wr * 64 + m * 16 + fr;
                        f32x4 v0 = acc[ai][bj][m][0], v1 = acc[ai][bj][m][1];
                        int key = row;
                        if (lat) {
                            const int t = (row - NCTX) & 1023, b = (row - NCTX) >> 10;
                            key = NCTX + 1536 * b + 512 + t;
                            const int p = (fq < 2) ? (t >> 6) : (t & 63);
                            rope8(v0, v1, (float)p, fq);
                        } else { float* p = out_krope + (size_t)row * 32 + fq * 8; *(f32x4*)p = v0; *(f32x4*)(p + 4) = v1; }
                        *(u32x4*)(kr + (size_t)key * 32 + fq * 8) = pack8(v0, v1);
                    }
            }
        }
    }
};
struct Epi2 {
    static constexpr bool PERM = true, AFTER_DRAIN = false;
    bf16_t* q; const float* ssq; const float* rope;
    __device__ __forceinline__ void operator()(const f32x4 (&acc)[2][2][4][2], const Unit& u, int wr, int wc, int fr, int fq) const {
        const bool lat = u.pm >= 16;
#pragma unroll
        for (int ai = 0; ai < 2; ++ai) {
            float rsv[4];
#pragma unroll
            for (int m = 0; m < 4; ++m) {
                const f32x4* sp = (const f32x4*)(ssq + (size_t)(u.pm * 256 + ai * 128 + wr * 64 + m * 16 + fr) * SSQS);
                const f32x4 a = sp[0], b = sp[1], c = sp[2];
                rsv[m] = ((a[0] + a[1]) + (a[2] + a[3])) + ((b[0] + b[1]) + (b[2] + b[3])) + ((c[0] + c[1]) + (c[2] + c[3]));
            }
#pragma unroll
            for (int m = 0; m < 4; ++m) {
                const int row = u.pm * 256 + ai * 128 + wr * 64 + m * 16 + fr;
                const float rs = __builtin_amdgcn_rsqf(rsv[m] * (1.f / 384.f) + EPS) * QSCALE;
                const int t = (row - NCTX) & 1023;
#pragma unroll
                for (int bj = 0; bj < 2; ++bj) {
                    const int col0 = u.pn * 256 + bj * 128 + wc * 32;
                    f32x4 v0 = acc[ai][bj][m][0] * rs, v1 = acc[ai][bj][m][1] * rs;
                    if (lat && (col0 % 96) == 64) { const int p = (fq < 2) ? (t >> 6) : (t & 63); rope8(v0, v1, (float)p, fq); }
                    *(u32x4*)(q + (size_t)row * 768 + col0 + fq * 8) = pack8(v0, v1);
                }
                asm volatile("" ::: "memory");
            }
        }
    }
};
struct Epi3 {
    static constexpr bool PERM = true, AFTER_DRAIN = false;
    bf16_t* kn; bf16_t* vt; const float* ssq;
    __device__ __forceinline__ void operator()(const f32x4 (&acc)[2][2][4][2], const Unit& u, int wr, int wc, int fr, int fq) const {
#pragma unroll
        for (int ai = 0; ai < 2; ++ai) {
            float rsv[4];
#pragma unroll
            for (int m = 0; m < 4; ++m) {
                rsv[m] = 1.f;
                if (u.pm < 32) { const f32x4* sp = (const f32x4*)(ssq + (size_t)(u.pm * 256 + ai * 128 + wr * 64 + m * 16 + fr) * SSQS + 12);
                    const f32x4 a = sp[0], b = sp[1];
                    rsv[m] = __builtin_amdgcn_rsqf((((a[0] + a[1]) + (a[2] + a[3])) + ((b[0] + b[1]) + (b[2] + b[3]))) * (1.f / 256.f) + EPS); }
            }
#pragma unroll
            for (int m = 0; m < 4; ++m) {
                const int row = u.pm * 256 + ai * 128 + wr * 64 + m * 16 + fr;
                const float rs = rsv[m]; int key;
                if (u.pm < 32) key = (u.pm < 16) ? row : NCTX + 1536 * ((row - NCTX) >> 10) + 512 + ((row - NCTX) & 1023);
                else { const int j = row - NTOK; key = NCTX + 1536 * (j >> 9) + (j & 511); }
#pragma unroll
                for (int bj = 0; bj < 2; ++bj) {
                    const int h = u.pn * 2 + bj;
                    const f32x4 v0 = acc[ai][bj][m][0] * rs, v1 = acc[ai][bj][m][1] * rs;
                    if (wc < 2) *(u32x4*)(kn + ((size_t)h * NKEY + key) * 64 + wc * 32 + fq * 8) = pack8(v0, v1);
                    else { bf16_t* dst = vt + ((size_t)h * 64 + (wc - 2) * 32 + fq * 8) * NKEY + key;
#pragma unroll
                        for (int e = 0; e < 4; ++e) { dst[(size_t)e * NKEY] = (bf16_t)f2bf(v0[e]); dst[(size_t)(e + 4) * NKEY] = (bf16_t)f2bf(v1[e]); } }
                }
                asm volatile("" ::: "memory");
            }
        }
    }
};
struct EpiF32 {
    static constexpr bool PERM = true, AFTER_DRAIN = false;
    bf16_t* p0; bf16_t* p1;
    __device__ __forceinline__ void operator()(const f32x4 (&acc)[2][2][4][2], const Unit& u, int wr, int wc, int fr, int fq) const {
        bf16_t* out = u.koff ? p1 : p0;
#pragma unroll
        for (int ai = 0; ai < 2; ++ai)
#pragma unroll
            for (int m = 0; m < 4; ++m) {
                const int row = u.pm * 256 + ai * 128 + wr * 64 + m * 16 + fr;
#pragma unroll
                for (int bj = 0; bj < 2; ++bj) *(u32x4*)(out + (size_t)row * D + u.pn * 256 + bj * 128 + wc * 32 + fq * 8) = pack8(acc[ai][bj][m][0], acc[ai][bj][m][1]);
            }
    }
};
struct SplitOrder {
    pg8::StaticOrder so; int G, c, ksz;
    __device__ void init(int M, int N, int ksz_, int G_, int c_) { so.init(M, N, 1, 0); G = G_; c = c_; ksz = ksz_; }
    __device__ bool next(int i, Unit& u) const { const int L = i * G + c; if (L >= 2 * so.nwg) return false; const int sp = L / so.nwg; so.next(L - sp * so.nwg, u); u.koff = sp * ksz; return true; }
    __device__ __forceinline__ void a_ready(const Unit&) const {}
    __device__ __forceinline__ void done(const Unit&) const {}
};
struct EpiPlain {
    static constexpr bool PERM = true, AFTER_DRAIN = false;
    bf16_t* O; int ldc;
    __device__ __forceinline__ void operator()(const f32x4 (&acc)[2][2][4][2], const Unit& u, int wr, int wc, int fr, int fq) const {
#pragma unroll
        for (int ai = 0; ai < 2; ++ai)
#pragma unroll
            for (int m = 0; m < 4; ++m) {
                const int row = u.pm * 256 + ai * 128 + wr * 64 + m * 16 + fr;
#pragma unroll
                for (int bj = 0; bj < 2; ++bj)
                    *(u32x4*)(O + (size_t)row * ldc + u.pn * 256 + bj * 128 + wc * 32 + fq * 8) = pack8(acc[ai][bj][m][0], acc[ai][bj][m][1]);
            }
    }
};

__device__ __forceinline__ float dpp_ror1(float v) { return __builtin_bit_cast(float, __builtin_amdgcn_update_dpp(0, __builtin_bit_cast(int, v), 0x121, 0xf, 0xf, false)); }
__device__ __forceinline__ float dpp_ror15(float v) { return __builtin_bit_cast(float, __builtin_amdgcn_update_dpp(0, __builtin_bit_cast(int, v), 0x12F, 0xf, 0xf, false)); }
struct EpiConv {
    static constexpr bool PERM = true, AFTER_DRAIN = false;
    bf16_t* G; float* SB; const float* cw; const float* cb;
    __device__ __forceinline__ void operator()(const f32x4 (&acc)[2][2][4][2], const Unit& u, int wr, int wc, int fr, int fq) const {
        const int ch0 = u.pn * 128 + wc * 32 + fq * 8;
        for (int dup = 0; dup < DUP_EC; ++dup)
#pragma unroll
        for (int n = 0; n < 2; ++n) {
            const int ch = ch0 + 4 * n;
            f32x4 wg[3], wv[3];
#pragma unroll
            for (int k = 0; k < 3; ++k) { wg[k] = *(const f32x4*)(cw + k * DFF2 + ch); wv[k] = *(const f32x4*)(cw + k * DFF2 + DFF + ch); }
            const f32x4 bg = *(const f32x4*)(cb + ch), bv = *(const f32x4*)(cb + DFF + ch);
#pragma unroll
            for (int ai = 0; ai < 2; ++ai) {
                const int rb = u.pm * 256 + ai * 128 + wr * 64;
#pragma unroll
                for (int m = 0; m < 4; ++m) {
                    const int row = rb + m * 16 + fr;
                    f32x4 r[2];
#pragma unroll
                    for (int bj = 0; bj < 2; ++bj) {
                        const f32x4 cur = acc[ai][bj][m][n];
                        const f32x4 wk0 = bj ? wv[0] : wg[0], wk1 = bj ? wv[1] : wg[1], wk2 = bj ? wv[2] : wg[2], bb = bj ? bv : bg;
#pragma unroll
                        for (int e = 0; e < 4; ++e) {
                            const float up = (m > 0) ? acc[ai][bj][m > 0 ? m - 1 : 0][n][e] : 0.f, dn = (m < 3) ? acc[ai][bj][m < 3 ? m + 1 : 3][n][e] : 0.f;
                            const float prev = dpp_ror1(fr == 15 ? up : cur[e]), next = dpp_ror15(fr == 0 ? dn : cur[e]);
                            r[bj][e] = bb[e] + wk0[e] * prev + wk1[e] * cur[e] + wk2[e] * next;
                        }
                        if ((m == 0 && fr < 2) || (m == 3 && fr >= 14)) {
                            const int ridx = (m == 0) ? fr : fr - 12;
                            *(f32x4*)(SB + ((size_t)((rb >> 6) * 4 + ridx) * 2 + bj) * DFF + ch) = cur;
                        }
                    }
                    u32x2 w;
#define SILU_MUL(g_, v_) ((g_) * __builtin_amdgcn_rcpf(1.f + __builtin_amdgcn_exp2f(-1.4426950408889634f * (g_))) * (v_))
                    w.x = cvt_pk_bf16(SILU_MUL(r[0][0], r[1][0]), SILU_MUL(r[0][1], r[1][1]));
                    w.y = cvt_pk_bf16(SILU_MUL(r[0][2], r[1][2]), SILU_MUL(r[0][3], r[1][3]));
                    *(u32x2*)(G + (size_t)row * DFF + ch) = w;
                }
            }
        }
    }
};

struct TrItem { const float* W; bf16_t* WT; int N, K, src_n0, dst_n0, k0; };
__device__ __forceinline__ void tr_load(const TrItem& t, f32x4 (&v)[8], int lane) {
    const float* ub = t.W + (size_t)t.k0 * t.N + t.src_n0; const int lo_ = (lane >> 3) * t.N + 4 * (lane & 7);
#pragma unroll
    for (int i = 0; i < 8; ++i) v[i] = __builtin_nontemporal_load((const f32x4*)(ub + (size_t)(8 * i) * t.N + lo_));
}
__device__ __forceinline__ void tr_store(const TrItem& t, const f32x4 (&v)[8], LAS float* scr, int lane) {
#pragma unroll
    for (int i = 0; i < 8; ++i) { LAS float* d = scr + (8 * i + (lane >> 3)) * 33 + 4 * (lane & 7); d[0] = v[i][0]; d[1] = v[i][1]; d[2] = v[i][2]; d[3] = v[i][3]; }
    asm volatile("s_waitcnt lgkmcnt(0)" ::: "memory");
    const int c = lane & 7;
#pragma unroll
    for (int j = 0; j < 4; ++j) { const int n = (lane >> 3) + 8 * j; const LAS float* sp = scr + (8 * c) * 33 + n;
        u32x4 o; o.x = cvt_pk_bf16(sp[0 * 33], sp[1 * 33]); o.y = cvt_pk_bf16(sp[2 * 33], sp[3 * 33]); o.z = cvt_pk_bf16(sp[4 * 33], sp[5 * 33]); o.w = cvt_pk_bf16(sp[6 * 33], sp[7 * 33]);
        *(u32x4*)(t.WT + (size_t)(t.dst_n0 + n) * t.K + t.k0 + 8 * c) = o; }
    asm volatile("s_waitcnt lgkmcnt(0)" ::: "memory");
}
__device__ __forceinline__ int win_src_col(int j) { if (j < 640) return j; if (j >= 1664) return 640 + (j - 1664); const int h = (j - 640) >> 7, w = (j - 640) & 127; return (h & 1) ? 672 + (h >> 1) * 128 + w : 1184 + (h >> 1) * 128 + w; }

constexpr int TI1 = 16 * 53, TI2 = 6 * 24, TI3 = 4 * 32, TI4 = 16 * 32, TI5 = 16 * 176, TI6 = 44 * 32, TNIT = TI1 + TI2 + TI3 + TI4 + TI5 + TI6, TSPLIT = 1792;
__device__ __forceinline__ void transpose_items(const Args& a, unsigned char* ws, LAS float* scr, int first, int last, int w, int nw, int lane) {
#define TR_DECODE(t, it_) do { int r = (it_); \
        if (r < TI1) { const int kb = r / 53, nb = r % 53; t = TrItem{a.in[9], (bf16_t*)(ws + WS_WT1), INW, 1024, win_src_col(32 * nb), 32 * nb, 64 * kb}; } \
        else if ((r -= TI1) < TI2) { const int kb = r / 24, nb = r % 24; t = TrItem{a.in[11], (bf16_t*)(ws + WS_WTQ), 768, 384, 32 * nb, 32 * nb, 64 * kb}; } \
        else if ((r -= TI2) < TI3) { const int kb = r / 32, nb = r % 32; t = TrItem{a.in[13], (bf16_t*)(ws + WS_WTKV), 1024, 256, 32 * nb, 32 * nb, 64 * kb}; } \
        else if ((r -= TI3) < TI4) { const int kb = r / 32, nb = r % 32; t = TrItem{a.in[19], (bf16_t*)(ws + WS_WTO), 1024, 1024, 32 * nb, 32 * nb, 64 * kb}; } \
        else if ((r -= TI4) < TI5) { const int kb = r / 176, nb = r % 176; t = TrItem{a.in[21], (bf16_t*)(ws + WS_WTUP), DFF2, 1024, ((nb >> 2) & 1) * DFF + (nb >> 3) * 128 + (nb & 3) * 32, 32 * nb, 64 * kb}; } \
        else { r -= TI5; const int kb = r / 32, nb = r % 32; t = TrItem{a.in[24], (bf16_t*)(ws + WS_WTDN), 1024, DFF, 32 * nb, 32 * nb, 64 * kb}; } } while (0)
    for (int itb = first + w; itb < last; itb += 3 * nw) {
        const int it1 = itb + nw, it2 = itb + 2 * nw;
        TrItem t0, t1, t2; f32x4 va[8], vb[8];
        TR_DECODE(t0, itb); tr_load(t0, va, lane);
        if (it1 < last) { TR_DECODE(t1, it1); tr_load(t1, vb, lane); }
        tr_store(t0, va, scr, lane);
        if (it2 < last) { TR_DECODE(t2, it2); tr_load(t2, va, lane); }
        if (it1 < last) tr_store(t1, vb, scr, lane);
        if (it2 < last) tr_store(t2, va, scr, lane);
    }
#undef TR_DECODE
}

__device__ __forceinline__ void norm_rows(const float* src_lo, const float* src_hi, const float* g, const float* mods, int off_shift, int off_scale, bf16_t* dstb, int gw, int ngw, int lane) {
    for (int row0 = gw; row0 < NTOK; row0 += 4 * ngw) {
        f32x4 v[4][4];
#pragma unroll
        for (int p = 0; p < 4; ++p) { const int row = row0 + p * ngw; if (row < NTOK) { const float* xr = (row < NCTX ? src_lo : src_hi) + (size_t)row * D;
#pragma unroll
            for (int j = 0; j < 4; ++j) v[p][j] = __builtin_nontemporal_load((const f32x4*)(xr + 4 * lane + 256 * j)); } }
        f32x4 gg[4];
#pragma unroll
        for (int j = 0; j < 4; ++j) gg[j] = *(const f32x4*)(g + 4 * lane + 256 * j);
#pragma unroll
        for (int p = 0; p < 4; ++p) { const int row = row0 + p * ngw; if (row < NTOK) {
            const float* mp = mods + (size_t)mod_of_row(row) * 6144;
            f32x4 sh[4], sc[4];
#pragma unroll
            for (int j = 0; j < 4; ++j) { sh[j] = *(const f32x4*)(mp + off_shift + 4 * lane + 256 * j); sc[j] = *(const f32x4*)(mp + off_scale + 4 * lane + 256 * j); }
            float s = 0.f;
#pragma unroll
            for (int j = 0; j < 4; ++j) s += dot4(v[p][j]);
            const float rstd = 1.0f / sqrtf(wave_sum(s) * (1.f / D) + EPS);
#pragma unroll
            for (int j = 0; j < 4; ++j) { const int col = 4 * lane + 256 * j;
                const f32x4 o = v[p][j] * rstd * gg[j] * (sc[j] + 1.f) + sh[j];
                u32x2 w; w.x = cvt_pk_bf16(o[0], o[1]); w.y = cvt_pk_bf16(o[2], o[3]);
                *(u32x2*)(dstb + (size_t)row * D + col) = w; } } }
    }
}

constexpr int AT_KSTR = 208, AT_VSTR = 136, AT_KBYTES = 64 * AT_KSTR, AT_VBYTES = 64 * AT_VSTR, AT_BUF = AT_KBYTES + AT_VBYTES;
__device__ __forceinline__ void attn_unit(LAS unsigned char* lds, const bf16_t* Q, const bf16_t* KN, const bf16_t* KR, const bf16_t* VT, bf16_t* MIX, const float* og, float* SSQA,
                                          int qrow0, int head, int kbase, int nkeys) {
    const int tid = threadIdx.x, lane = tid & 63, wid = tid >> 6, r32 = lane & 31, hi = lane >> 5;
    const int qg = wid & 3, kh = wid >> 2, ht = tid & 255;
    const int qrow = qrow0 + qg * 32 + r32;
    bf16x8 qf[6];
    { const bf16_t* qp = Q + (size_t)qrow * 768 + head * 96 + hi * 8;
#pragma unroll
      for (int d0 = 0; d0 < 6; ++d0) qf[d0] = __builtin_nontemporal_load((const bf16x8*)(qp + d0 * 16)); }
    const int nk2 = nkeys >> 1, k0 = kbase + kh * nk2, NT = nk2 >> 6;
    const bf16_t* knp = KN + ((size_t)head * NKEY + k0) * 64;
    const bf16_t* krp = KR + (size_t)k0 * 32;
    const bf16_t* vtp = VT + (size_t)head * 64 * NKEY + k0;
    u32x4 gA[5], gB[5];
#define AT_LOAD(R, t) do { const int kk = (t) * 64; \
        R[0] = *(const u32x4*)(knp + (size_t)(kk + (ht >> 3)) * 64 + (ht & 7) * 8); R[1] = *(const u32x4*)(knp + (size_t)(kk + 32 + (ht >> 3)) * 64 + (ht & 7) * 8); \
        R[2] = *(const u32x4*)(krp + (size_t)(kk + (ht >> 2)) * 32 + (ht & 3) * 8); \
        R[3] = *(const u32x4*)(vtp + (size_t)(ht >> 3) * NKEY + kk + (ht & 7) * 8); R[4] = *(const u32x4*)(vtp + (size_t)(32 + (ht >> 3)) * NKEY + kk + (ht & 7) * 8); } while (0)
#define AT_STORE(R, b) do { LAS unsigned char* kb_ = lds + (kh * 2 + (b)) * AT_BUF; LAS unsigned char* vb_ = kb_ + AT_KBYTES; \
        *(LAS u32x4*)(kb_ + (ht >> 3) * AT_KSTR + (ht & 7) * 16) = R[0]; *(LAS u32x4*)(kb_ + (32 + (ht >> 3)) * AT_KSTR + (ht & 7) * 16) = R[1]; \
        *(LAS u32x4*)(kb_ + (ht >> 2) * AT_KSTR + 128 + (ht & 3) * 16) = R[2]; \
        *(LAS u32x2*)(vb_ + (ht >> 3) * AT_VSTR + (ht & 7) * 16) = (u32x2){R[3].x, R[3].y}; *(LAS u32x2*)(vb_ + (ht >> 3) * AT_VSTR + (ht & 7) * 16 + 8) = (u32x2){R[3].z, R[3].w}; \
        *(LAS u32x2*)(vb_ + (32 + (ht >> 3)) * AT_VSTR + (ht & 7) * 16) = (u32x2){R[4].x, R[4].y}; *(LAS u32x2*)(vb_ + (32 + (ht >> 3)) * AT_VSTR + (ht & 7) * 16 + 8) = (u32x2){R[4].z, R[4].w}; } while (0)
    float m_run = 0.f, l_run = 0.f;
    f32x16 o0, o1, negm;
#pragma unroll
    for (int r = 0; r < 16; ++r) { o0[r] = 0.f; o1[r] = 0.f; negm[r] = 0.f; }
#define AT_COMPUTE(b, first) do { \
        const LAS unsigned char* kb = lds + (kh * 2 + (b)) * AT_BUF; const LAS unsigned char* vb = kb + AT_KBYTES; \
        f32x16 s0, s1; \
        _Pragma("unroll") for (int d0 = 0; d0 < 6; ++d0) { \
            const bf16x8 k0f = *(const LAS bf16x8*)(kb + r32 * AT_KSTR + d0 * 32 + hi * 16); \
            const bf16x8 k1f = *(const LAS bf16x8*)(kb + (32 + r32) * AT_KSTR + d0 * 32 + hi * 16); \
            if (d0 == 0) { s0 = __builtin_amdgcn_mfma_f32_32x32x16_bf16(k0f, qf[0], negm, 0, 0, 0); s1 = __builtin_amdgcn_mfma_f32_32x32x16_bf16(k1f, qf[0], negm, 0, 0, 0); } \
            else { s0 = __builtin_amdgcn_mfma_f32_32x32x16_bf16(k0f, qf[d0], s0, 0, 0, 0); s1 = __builtin_amdgcn_mfma_f32_32x32x16_bf16(k1f, qf[d0], s1, 0, 0, 0); } } \
        float mx = fmaxf(s0[0], s1[0]); \
        _Pragma("unroll") for (int r = 1; r < 16; ++r) mx = fmaxf(mx, fmaxf(s0[r], s1[r])); \
        mx = fmaxf(mx, __shfl_xor(mx, 32)); \
        if ((first) || __any(mx > 8.0f)) { \
            const float dl = (first) ? mx : fmaxf(mx, 0.f), alpha = (first) ? 0.f : __builtin_amdgcn_exp2f(-dl); \
            m_run += dl; l_run *= alpha; \
            _Pragma("unroll") for (int r = 0; r < 16; ++r) { s0[r] -= dl; s1[r] -= dl; o0[r] *= alpha; o1[r] *= alpha; negm[r] = -m_run; } } \
        float ls = 0.f; \
        _Pragma("unroll") for (int r = 0; r < 16; ++r) { s0[r] = __builtin_amdgcn_exp2f(s0[r]); s1[r] = __builtin_amdgcn_exp2f(s1[r]); ls += s0[r] + s1[r]; } \
        l_run += ls; \
        u32x4 pb[4]; \
        pb[0] = pack8((f32x4){s0[0], s0[1], s0[2], s0[3]}, (f32x4){s0[4], s0[5], s0[6], s0[7]}); \
        pb[1] = pack8((f32x4){s0[8], s0[9], s0[10], s0[11]}, (f32x4){s0[12], s0[13], s0[14], s0[15]}); \
        pb[2] = pack8((f32x4){s1[0], s1[1], s1[2], s1[3]}, (f32x4){s1[4], s1[5], s1[6], s1[7]}); \
        pb[3] = pack8((f32x4){s1[8], s1[9], s1[10], s1[11]}, (f32x4){s1[12], s1[13], s1[14], s1[15]}); \
        _Pragma("unroll") for (int ks = 0; ks < 4; ++ks) { \
            const bf16x8 pf = __builtin_bit_cast(bf16x8, pb[ks]); \
            const LAS unsigned char* vp = vb + r32 * AT_VSTR + ks * 32 + hi * 8; \
            const u32x2 a0 = *(const LAS u32x2*)(vp), a1 = *(const LAS u32x2*)(vp + 16); \
            const u32x2 c0 = *(const LAS u32x2*)(vp + 32 * AT_VSTR), c1 = *(const LAS u32x2*)(vp + 32 * AT_VSTR + 16); \
            o0 = __builtin_amdgcn_mfma_f32_32x32x16_bf16(__builtin_bit_cast(bf16x8, (u32x4){a0.x, a0.y, a1.x, a1.y}), pf, o0, 0, 0, 0); \
            o1 = __builtin_amdgcn_mfma_f32_32x32x16_bf16(__builtin_bit_cast(bf16x8, (u32x4){c0.x, c0.y, c1.x, c1.y}), pf, o1, 0, 0, 0); } } while (0)
    AT_LOAD(gA, 0); AT_LOAD(gB, 1);
    for (int t = 0; t < NT; t += 2) {
        AT_STORE(gA, 0);
        __syncthreads();
        if (t + 2 < NT) AT_LOAD(gA, t + 2);
        AT_COMPUTE(0, t == 0);
        AT_STORE(gB, 1);
        __syncthreads();
        if (t + 3 < NT) AT_LOAD(gB, t + 3);
        AT_COMPUTE(1, false);
    }
#undef AT_LOAD
#undef AT_STORE
#undef AT_COMPUTE
    l_run += __shfl_xor(l_run, 32);
    __syncthreads();
    LAS float* cb = (LAS float*)lds + (qg * 64 + lane) * 35;
    if (kh == 1) {
        cb[0] = m_run; cb[1] = l_run;
#pragma unroll
        for (int r = 0; r < 16; ++r) { cb[2 + r] = o0[r]; cb[18 + r] = o1[r]; }
    }
    __syncthreads();
    if (kh == 0) {
        const float m1 = cb[0], l1 = cb[1];
        const float mn = fmaxf(m_run, m1), a0 = __builtin_amdgcn_exp2f(m_run - mn), a1 = __builtin_amdgcn_exp2f(m1 - mn);
        const float inv = 1.0f / (l_run * a0 + l1 * a1);
        float ss = 0.f;
#pragma unroll
        for (int r = 0; r < 16; ++r) { o0[r] = (o0[r] * a0 + cb[2 + r] * a1) * inv; o1[r] = (o1[r] * a0 + cb[18 + r] * a1) * inv; ss += o0[r] * o0[r] + o1[r] * o1[r]; }
        ss += __shfl_xor(ss, 32);
        bf16_t* op = MIX + (size_t)qrow * D + head * 64 + 4 * hi; const float* gp = og + head * 64 + 4 * hi;
#pragma unroll
        for (int g4 = 0; g4 < 4; ++g4) {
            const f32x4 ga = *(const f32x4*)(gp + 8 * g4), gb = *(const f32x4*)(gp + 32 + 8 * g4);
            u32x2 w; w.x = cvt_pk_bf16(o0[4 * g4] * ga[0], o0[4 * g4 + 1] * ga[1]); w.y = cvt_pk_bf16(o0[4 * g4 + 2] * ga[2], o0[4 * g4 + 3] * ga[3]);
            *(u32x2*)(op + 8 * g4) = w;
            w.x = cvt_pk_bf16(o1[4 * g4] * gb[0], o1[4 * g4 + 1] * gb[1]); w.y = cvt_pk_bf16(o1[4 * g4 + 2] * gb[2], o1[4 * g4 + 3] * gb[3]);
            *(u32x2*)(op + 32 + 8 * g4) = w;
        }
        if (hi == 0) SSQA[(size_t)qrow * 8 + head] = ss;
    }
    __syncthreads();
}

#define BFLO(w) __uint_as_float((w) << 16)
#define BFHI(w) __uint_as_float((w) & 0xffff0000u)
__device__ __forceinline__ void spatial_unit(LAS unsigned char* lds, int chunk, int g, const bf16_t* GVT, const bf16_t* GU, const float* SSQ1, const float* w_s, const float* b_s,
                                             const float* vg, const float* og, bf16_t* MIX, float* SSQG) {
    const int tid = threadIdx.x, lane = tid & 63, wid = tid >> 6, r32 = lane & 31, hi = lane >> 5;
    const int ih = wid & 3, ch = wid >> 2, t0 = chunk * 128, i = ih * 32 + r32;
    LAS float* rv = (LAS float*)lds;
    f32x4 pss = (f32x4){0.f, 0.f, 0.f, 0.f};
    if (tid < 128) pss = *(const f32x4*)(SSQ1 + (size_t)(t0 + tid) * SSQS + 20 + 4 * g);
    f32x4 wv[8][2]; bf16x8 af[2][8];
#pragma unroll
    for (int ks = 0; ks < 8; ++ks) { const float* wp = w_s + ((size_t)g * 128 + i) * 128 + 16 * ks + 8 * hi; wv[ks][0] = *(const f32x4*)wp; wv[ks][1] = *(const f32x4*)(wp + 4);
#pragma unroll
        for (int ct = 0; ct < 2; ++ct) af[ct][ks] = *(const bf16x8*)(GVT + (size_t)(g * 128 + ch * 64 + ct * 32 + r32) * NTOK + t0 + 16 * ks + 8 * hi); }
    const float bs = b_s[g * 128 + i];
    u32x2 guw[2][4];
#pragma unroll
    for (int ct = 0; ct < 2; ++ct)
#pragma unroll
        for (int g4 = 0; g4 < 4; ++g4) guw[ct][g4] = __builtin_nontemporal_load((const u32x2*)(GU + (size_t)(t0 + i) * 512 + g * 128 + ch * 64 + ct * 32 + 8 * g4 + 4 * hi));
    if (tid < 128) rv[tid] = __builtin_amdgcn_rsqf(((pss[0] + pss[1]) + (pss[2] + pss[3])) * (1.f / 128.f) + EPS);
    __syncthreads();
    f32x16 acc[2];
#pragma unroll
    for (int r = 0; r < 16; ++r) { acc[0][r] = 0.f; acc[1][r] = 0.f; }
#pragma unroll
    for (int ks = 0; ks < 8; ++ks) {
        const int j0 = 16 * ks + 8 * hi;
        f32x4 w0 = wv[ks][0], w1 = wv[ks][1];
#pragma unroll
        for (int e = 0; e < 4; ++e) { w0[e] *= rv[j0 + e]; w1[e] *= rv[j0 + 4 + e]; }
        const bf16x8 bf = __builtin_bit_cast(bf16x8, pack8(w0, w1));
        acc[0] = __builtin_amdgcn_mfma_f32_32x32x16_bf16(af[0][ks], bf, acc[0], 0, 0, 0);
        acc[1] = __builtin_amdgcn_mfma_f32_32x32x16_bf16(af[1][ks], bf, acc[1], 0, 0, 0);
    }
    float ssq = 0.f;
#pragma unroll
    for (int ct = 0; ct < 2; ++ct)
#pragma unroll
        for (int g4 = 0; g4 < 4; ++g4) {
            const int cb = g * 128 + ch * 64 + ct * 32 + 8 * g4 + 4 * hi;
            const f32x4 vgv = *(const f32x4*)(vg + cb), ogv = *(const f32x4*)(og + cb);
            const u32x2 gq = guw[ct][g4];
            const float o0 = BFLO(gq.x) * (acc[ct][4 * g4 + 0] * vgv[0] + bs), o1 = BFHI(gq.x) * (acc[ct][4 * g4 + 1] * vgv[1] + bs);
            const float o2 = BFLO(gq.y) * (acc[ct][4 * g4 + 2] * vgv[2] + bs), o3 = BFHI(gq.y) * (acc[ct][4 * g4 + 3] * vgv[3] + bs);
            ssq += (o0 * o0 + o1 * o1) + (o2 * o2 + o3 * o3);
            u32x2 w; w.x = cvt_pk_bf16(o0 * ogv[0], o1 * ogv[1]); w.y = cvt_pk_bf16(o2 * ogv[2], o3 * ogv[3]);
            *(u32x2*)(MIX + (size_t)(t0 + i) * D + 512 + cb) = w;
        }
    ssq += __shfl_xor(ssq, 32);
    if (hi == 0) SSQG[(size_t)(t0 + i) * 8 + g * 2 + ch] = ssq;
    __syncthreads();
}


#define XB_TMO      128
#define XB_XCNT(j)  (256  + 64 * (j))
#define XB_XSUB(j)  (1280 + 64 * (j))
#define XB_XGEN(j)  (2304 + 64 * (j))
#define XB_TOP      3328
#define XB_TOPGEN   3392
#define XCD_BAR_WORDS 3456
#define XB_SPIN_CAP (1u << 18)

__device__ __forceinline__ unsigned xb_ld(unsigned* p)              { return __hip_atomic_load(p, __ATOMIC_RELAXED, __HIP_MEMORY_SCOPE_AGENT); }
__device__ __forceinline__ unsigned xb_add(unsigned* p, unsigned v) { return __hip_atomic_fetch_add(p, v, __ATOMIC_RELAXED, __HIP_MEMORY_SCOPE_AGENT); }
__device__ __forceinline__ unsigned xb_xcc_id() { return (unsigned)__builtin_amdgcn_s_getreg((3 << 11) | 20) & 0xFu; }
#define XB_SPIN(cond, bar) do { unsigned _sp = 0; while (cond) { __builtin_amdgcn_s_sleep(1); \
    if ((++_sp & 255u) == 0u) { if (xb_ld(&(bar)[XB_TMO])) break; if (_sp > XB_SPIN_CAP) { atomicAdd(&(bar)[XB_TMO], 1u); break; } } } } while (0)

struct XcdBarrier {
    unsigned* bar; unsigned x;
    volatile LAS unsigned* st;
};

__device__ __forceinline__ XcdBarrier xcd_barrier_post(unsigned* bar, volatile LAS unsigned* st) {
    XcdBarrier b; b.bar = bar; b.x = xb_xcc_id(); b.st = st;
    if (threadIdx.x == 0) (void)xb_add(&bar[XB_XCNT(b.x)], 1u);
    return b;
}
__device__ __forceinline__ void xcd_barrier_complete(unsigned* bar, unsigned x, unsigned& nloc, unsigned& nx) {
    const unsigned G = gridDim.x * gridDim.y * gridDim.z;
    unsigned sum, cnt, mine, sp = 0u;
    for (;;) {
        sum = 0u; cnt = 0u; mine = 0u;
#pragma unroll
        for (unsigned j = 0; j < 16; ++j) { const unsigned c = xb_ld(&bar[XB_XCNT(j)]); sum += c; cnt += (c > 0u) ? 1u : 0u; mine = (j == x) ? c : mine; }
        if (sum == G) break;
        __builtin_amdgcn_s_sleep(1);
        if ((++sp & 255u) == 0u) { if (xb_ld(&bar[XB_TMO])) break; if (sp > XB_SPIN_CAP) { atomicAdd(&bar[XB_TMO], 1u); break; } }
    }
    nloc = mine > 0u ? mine : 1u; nx = cnt > 0u ? cnt : 1u;
}

__device__ __forceinline__ void xcd_barrier(const XcdBarrier& b) {
    asm volatile("s_waitcnt vmcnt(0)" ::: "memory");
    __syncthreads();
    if (threadIdx.x == 0) {
        unsigned* bar = b.bar;
        __builtin_amdgcn_s_waitcnt(0);
        unsigned nloc = b.st[0], nx = b.st[1];
        if (nloc == 0u) { xcd_barrier_complete(bar, b.x, nloc, nx); b.st[0] = nloc; b.st[1] = nx; }
        const unsigned old = xb_add(&bar[XB_XSUB(b.x)], 1u);
        const unsigned gen = old / nloc;
        if (old + 1u == (gen + 1u) * nloc) {
            __builtin_amdgcn_fence(__ATOMIC_RELEASE, "agent");
            asm volatile("s_waitcnt vmcnt(0)" ::: "memory");
            const unsigned og = xb_add(&bar[XB_TOP], 1u);
            const unsigned tg = og / nx;
            if (og + 1u == (tg + 1u) * nx) xb_add(&bar[XB_TOPGEN], 1u);
            else XB_SPIN(xb_ld(&bar[XB_TOPGEN]) == tg, bar);
            __builtin_amdgcn_fence(__ATOMIC_ACQUIRE, "agent");
            xb_add(&bar[XB_XGEN(b.x)], 1u);
            asm volatile("s_waitcnt vmcnt(0)" ::: "memory");
        } else {
            XB_SPIN(xb_ld(&bar[XB_XGEN(b.x)]) == gen, bar);
            __builtin_amdgcn_fence(__ATOMIC_ACQUIRE, "agent");
            asm volatile("s_waitcnt vmcnt(0)" ::: "memory");
        }
    }
    __syncthreads();
}

__device__ __forceinline__ float sum8(const float* p) { const f32x4 a = *(const f32x4*)p, b = *(const f32x4*)(p + 4); return ((a[0] + a[1]) + (a[2] + a[3])) + ((b[0] + b[1]) + (b[2] + b[3])); }
__device__ __forceinline__ f32x4 ld_bf4(const bf16_t* p) { const u32x2 w = __builtin_nontemporal_load((const u32x2*)p); return (f32x4){BFLO(w.x), BFHI(w.x), BFLO(w.y), BFHI(w.y)}; }
__device__ __forceinline__ void rows_x1_h2(const float* xp, const float* xs_off, bf16_t* X1, const bf16_t* PA, const bf16_t* PG, const float* SSQA, const float* SSQG, const float* mods, const float* g2, bf16_t* H, int gw, int ngw, int lane) {
    for (int row0 = gw; row0 < NTOK; row0 += 2 * ngw) {
        f32x4 x[2][4], pa[2][4], pg[2][4]; float ra[2], rg[2];
#pragma unroll
        for (int p = 0; p < 2; ++p) { const int row = row0 + p * ngw; if (row < NTOK) {
            const float* xr = (row < NCTX ? xp : xs_off) + (size_t)row * D;
#pragma unroll
            for (int j = 0; j < 4; ++j) { const int col = 4 * lane + 256 * j; x[p][j] = __builtin_nontemporal_load((const f32x4*)(xr + col)); pa[p][j] = ld_bf4(PA + (size_t)row * D + col); pg[p][j] = ld_bf4(PG + (size_t)row * D + col); }
            ra[p] = sum8(SSQA + (size_t)row * 8); rg[p] = sum8(SSQG + (size_t)row * 8); } }
#pragma unroll
        for (int p = 0; p < 2; ++p) { const int row = row0 + p * ngw; if (row < NTOK) {
            const float* mp = mods + (size_t)mod_of_row(row) * 6144;
            const float fa = 1.0f / sqrtf(ra[p] * (1.f / 512.f) + EPS), fg = 1.0f / sqrtf(rg[p] * (1.f / 512.f) + EPS);
            float s = 0.f;
#pragma unroll
            for (int j = 0; j < 4; ++j) { const int col = 4 * lane + 256 * j; const f32x4 gt = *(const f32x4*)(mp + 2048 + col);
                x[p][j] = x[p][j] + gt * (pa[p][j] * fa + pg[p][j] * fg); s += dot4(x[p][j]); }
            const float rstd = 1.0f / sqrtf(wave_sum(s) * (1.f / D) + EPS);
#pragma unroll
            for (int j = 0; j < 4; ++j) { const int col = 4 * lane + 256 * j;
                { u32x2 wx; wx.x = cvt_pk_bf16(x[p][j][0], x[p][j][1]); wx.y = cvt_pk_bf16(x[p][j][2], x[p][j][3]); *(u32x2*)(X1 + (size_t)row * D + col) = wx; }
                const f32x4 gg = *(const f32x4*)(g2 + col), sh = *(const f32x4*)(mp + 3072 + col), sc = *(const f32x4*)(mp + 4096 + col);
                const f32x4 o = x[p][j] * rstd * gg * (sc + 1.f) + sh;
                u32x2 w; w.x = cvt_pk_bf16(o[0], o[1]); w.y = cvt_pk_bf16(o[2], o[3]);
                *(u32x2*)(H + (size_t)row * D + col) = w; } } }
    }
}
__device__ __forceinline__ void rows_final(const bf16_t* X1, const bf16_t* P0, const bf16_t* P1, const float* mods, const float* gf, float* out, int gw, int ngw, int lane) {
    for (int row0 = gw; row0 < NTOK; row0 += 2 * ngw) {
        f32x4 x[2][4], pa[2][4], pb[2][4];
#pragma unroll
        for (int p = 0; p < 2; ++p) { const int row = row0 + p * ngw; if (row < NTOK) {
#pragma unroll
            for (int j = 0; j < 4; ++j) { const size_t o = (size_t)row * D + 4 * lane + 256 * j; x[p][j] = ld_bf4(X1 + o); pa[p][j] = ld_bf4(P0 + o); pb[p][j] = ld_bf4(P1 + o); } } }
#pragma unroll
        for (int p = 0; p < 2; ++p) { const int row = row0 + p * ngw; if (row < NTOK) {
            const float* mp = mods + (size_t)mod_of_row(row) * 6144;
            float s = 0.f;
#pragma unroll
            for (int j = 0; j < 4; ++j) { const int col = 4 * lane + 256 * j; x[p][j] = x[p][j] + *(const f32x4*)(mp + 5120 + col) * (pa[p][j] + pb[p][j]); s += dot4(x[p][j]); }
            const float rstd = 1.0f / sqrtf(wave_sum(s) * (1.f / D) + EPS);
#pragma unroll
            for (int j = 0; j < 4; ++j) { const int col = 4 * lane + 256 * j; __builtin_nontemporal_store(x[p][j] * rstd * *(const f32x4*)(gf + col), (f32x4*)(out + (size_t)row * D + col)); } } }
    }
}

__device__ __forceinline__ void seam(int k, int lo, int hi_, const XcdBarrier& bar) { if (lo <= k && k + 1 < hi_) xcd_barrier(bar); }
__global__ void __launch_bounds__(512, 2) mk_fwd(Args a) {
    extern __shared__ __attribute__((aligned(16))) unsigned char lds_raw[];
    LAS unsigned char* lds = (LAS unsigned char*)lds_raw;
    cg::grid_group grid = cg::this_grid();
    const int tid = threadIdx.x, lane = tid & 63, wave = __builtin_amdgcn_readfirstlane(tid >> 6);
    const int G = gridDim.x, bx = blockIdx.x;
    const int vcu = (G % 8 == 0) ? (bx % 8) * (G / 8) + bx / 8 : bx;
    const int gw = bx * 8 + wave, ngw = G * 8;
    const int lo = a.ph_lo, hi_ = a.ph_hi;
    unsigned char* ws = a.ws;
    const float* xp = a.in[0]; const float* xs = a.in[1];
    volatile LAS unsigned* MISC = (volatile LAS unsigned*)(lds + 131072 + 320);
    if (tid < 32) MISC[tid] = 0u;
    __syncthreads();
    XcdBarrier bar = xcd_barrier_post((unsigned*)(ws + WS_CTL), MISC + 8);
#define WSP(T, off) ((T*)(ws + (off)))
    float* out_y = a.out; float* out_ckv = a.out + (size_t)NTOK * D; float* out_krope = out_ckv + (size_t)NCTX * 256;
#ifndef MK_SKIP
#define MK_SKIP 0
#endif
#define IN(k) (!((MK_SKIP >> (k)) & 1) && lo <= (k) && (k) < hi_)
#define PH(k) for (int d_ = 0; d_ < (IN(k) ? DUPP##k : 0); ++d_, seam(k, lo, hi_, bar))
#define SEAM(k) do { } while (0)
    if (lo < 0) grid.sync();

    PH(0) {
        bf16_t* WT1 = WSP(bf16_t, WS_WT1);
        const bool gv = bx < 192;
        f32x4 w4[16];
        if (gv) { const float* wb = a.in[6] + (size_t)(128 * wave) * 6144 + 32 * bx; const int lo_ = (lane >> 3) * 6144 + 4 * (lane & 7);
#pragma unroll
            for (int i = 0; i < 16; ++i) w4[i] = __builtin_nontemporal_load((const f32x4*)(wb + (size_t)(8 * i) * 6144 + lo_)); }
        LAS float* scond = (LAS float*)lds;
        LAS float* red = (LAS float*)(lds + 24576);
        if (gv) { float cv[10];
#pragma unroll
            for (int q = 0; q < 10; ++q) { const int idx = tid + 512 * q, c = idx >> 10, k = idx & 1023; cv[q] = (c == 0) ? a.in[5][k] : a.in[4][(c - 1) * 1024 + k]; }
#pragma unroll
            for (int q = 0; q < 10; ++q) scond[tid + 512 * q] = cv[q] * __builtin_amdgcn_rcpf(1.f + __expf(-cv[q])); }
        if (!gv) transpose_items(a, ws, (LAS float*)(lds + 32768 + wave * 8448), 0, TSPLIT, (bx - 192) * 8 + wave, (G - 192) * 8, lane);
        const int gt = bx * 512 + tid, ngt = G * 512;
        for (int idx = gt; idx < (INP - INW) * 1024 / 8; idx += ngt) *(u32x4*)(WT1 + (size_t)INW * 1024 + (size_t)idx * 8) = (u32x4){0u, 0u, 0u, 0u};
        for (int idx = gt; idx < 2048 * 256 / 4; idx += ngt) { const f32x4 v = __builtin_nontemporal_load((const f32x4*)(a.in[2] + (size_t)idx * 4)); u32x2 w; w.x = cvt_pk_bf16(v[0], v[1]); w.y = cvt_pk_bf16(v[2], v[3]);
            *(u32x2*)(WSP(bf16_t, WS_KVA) + (size_t)NTOK * 256 + (size_t)idx * 4) = w; }
        for (int idx = gt; idx < 2048 * 32 / 4; idx += ngt) { const f32x4 v = __builtin_nontemporal_load((const f32x4*)(a.in[3] + (size_t)idx * 4)); const int j = idx >> 3, c4 = idx & 7; u32x2 w; w.x = cvt_pk_bf16(v[0], v[1]); w.y = cvt_pk_bf16(v[2], v[3]);
            *(u32x2*)(WSP(bf16_t, WS_KR) + (size_t)(NCTX + 1536 * (j >> 9) + (j & 511)) * 32 + c4 * 4) = w; }
        if (gv) {
            __syncthreads();
            f32x4 acc5[5];
#pragma unroll
            for (int c = 0; c < 5; ++c) acc5[c] = (f32x4){0.f, 0.f, 0.f, 0.f};
#pragma unroll
            for (int i = 0; i < 16; ++i) { const int k = 128 * wave + 8 * i + (lane >> 3);
#pragma unroll
                for (int c = 0; c < 5; ++c) acc5[c] += w4[i] * scond[c * 1024 + k]; }
#pragma unroll
            for (int c = 0; c < 5; ++c)
#pragma unroll
                for (int e = 0; e < 4; ++e) { float v = acc5[c][e]; v += __shfl_xor(v, 8); v += __shfl_xor(v, 16); v += __shfl_xor(v, 32); if (lane < 8) red[(wave * 5 + c) * 32 + 4 * lane + e] = v; }
            __syncthreads();
            if (tid < 160) { const int c = tid >> 5, col = tid & 31; float sm = 0.f;
#pragma unroll
                for (int w = 0; w < 8; ++w) sm += red[(w * 5 + c) * 32 + col];
                WSP(float, WS_MODS)[c * 6144 + 32 * bx + col] = sm + a.in[7][32 * bx + col]; }
            __syncthreads();
        }
    }
    SEAM(0);
    PH(1) norm_rows(xp, xs - (size_t)NCTX * D, a.in[8], WSP(float, WS_MODS), 0, 1024, WSP(bf16_t, WS_H), gw, ngw, lane);
    SEAM(1);
    PH(2) {
        pg8::Gemm g{WSP(bf16_t, WS_H), WSP(bf16_t, WS_WT1), NTOK, INP, D, D, D}; pg8::StaticOrder S; S.init(NTOK, INP, G, bx);
        Epi1 E{WSP(bf16_t, WS_QLAT), WSP(bf16_t, WS_KVA), WSP(float, WS_KVRAW), WSP(bf16_t, WS_GVT), WSP(bf16_t, WS_GU), WSP(bf16_t, WS_KR), WSP(float, WS_SSQ1), out_krope, a.in[10], a.in[12], WSP(float, WS_ROPE)};
        pg8::gemm_phase<Epi1, pg8::StaticOrder, true, true>(lds, g, S, E);
        if (bx >= 224) transpose_items(a, ws, (LAS float*)(lds + wave * 8448), TSPLIT, TI1 + TI2 + TI3 + TI4 + TI5, (bx - 224) * 8 + wave, (G - 224) * 8, lane);
    }
    SEAM(2);
    PH(3) {
        if (bx < 96) { pg8::Gemm g{WSP(bf16_t, WS_QLAT), WSP(bf16_t, WS_WTQ), NTOK, 768, 384, 384, 384}; pg8::StaticOrder S; S.init(NTOK, 768, 96, bx); Epi2 E{WSP(bf16_t, WS_Q), WSP(float, WS_SSQ1), WSP(float, WS_ROPE)};
            pg8::gemm_phase<Epi2, pg8::StaticOrder, true, true>(lds, g, S, E); }
        else if (bx < 256) { pg8::Gemm g{WSP(bf16_t, WS_KVA), WSP(bf16_t, WS_WTKV), NKEY, 1024, 256, 256, 256}; pg8::StaticOrder S; S.init(NKEY, 1024, 160, bx - 96); Epi3 E{WSP(bf16_t, WS_KN), WSP(bf16_t, WS_VT), WSP(float, WS_SSQ1)};
            pg8::gemm_phase<Epi3, pg8::StaticOrder, true, true>(lds, g, S, E); }
    }
    SEAM(3);
    PH(4) {
        bf16_t* MIX = WSP(bf16_t, WS_MIX);
        for (int dup = 0; dup < DUP_ATT; ++dup)
        for (int u = vcu; u < 512; u += G) {
            if (u < 256) { const int seq = u >> 6, head = (u >> 3) & 7, qb = u & 7; attn_unit(lds, WSP(bf16_t, WS_Q), WSP(bf16_t, WS_KN), WSP(bf16_t, WS_KR), WSP(bf16_t, WS_VT), MIX, a.in[17], WSP(float, WS_SSQA), NCTX + seq * 1024 + qb * 128, head, NCTX + 1536 * seq, 1536); }
            else { const int v = u - 256, seq = v >> 4, head = (v >> 1) & 7, qb = v & 1; attn_unit(lds, WSP(bf16_t, WS_Q), WSP(bf16_t, WS_KN), WSP(bf16_t, WS_KR), WSP(bf16_t, WS_VT), MIX, a.in[17], WSP(float, WS_SSQA), seq * 256 + qb * 128, head, seq * 256, 256); }
        }
        for (int dup = 0; dup < DUP_SPA; ++dup)
        for (int u = vcu; u < 256; u += G) spatial_unit(lds, u >> 2, u & 3, WSP(bf16_t, WS_GVT), WSP(bf16_t, WS_GU), WSP(float, WS_SSQ1), a.in[15], a.in[16], a.in[14], a.in[18], MIX, WSP(float, WS_SSQG));
    }
    SEAM(4);
    PH(5) {
        pg8::Gemm g{WSP(bf16_t, WS_MIX), WSP(bf16_t, WS_WTO), NTOK, D, 512, D, D}; SplitOrder S; S.init(NTOK, D, 512, G, bx);
        EpiF32 E{WSP(bf16_t, WS_PA), WSP(bf16_t, WS_PG)};
        pg8::gemm_phase<EpiF32, SplitOrder, true, true>(lds, g, S, E);
    }
    SEAM(5);
    PH(6) rows_x1_h2(xp, xs - (size_t)NCTX * D, WSP(bf16_t, WS_X1), WSP(bf16_t, WS_PA), WSP(bf16_t, WS_PG), WSP(float, WS_SSQA), WSP(float, WS_SSQG), WSP(float, WS_MODS), a.in[20], WSP(bf16_t, WS_H), gw, ngw, lane);
    SEAM(6);
    PH(7) {
        pg8::Gemm g{WSP(bf16_t, WS_H), WSP(bf16_t, WS_WTUP), NTOK, DFF2, D, D, D}; pg8::StaticOrder S; S.init(NTOK, DFF2, G, bx);
        EpiConv E{WSP(bf16_t, WS_G), WSP(float, WS_SB), a.in[22], a.in[23]};
        pg8::gemm_phase<EpiConv, pg8::StaticOrder, true, true>(lds, g, S, E);
        if (bx >= 192) transpose_items(a, ws, (LAS float*)(lds + wave * 8448), TI1 + TI2 + TI3 + TI4 + TI5, TNIT, (bx - 192) * 8 + wave, (G - 192) * 8, lane);
    }
    SEAM(7);
    PH(8) {
        const float* cw = a.in[22]; const float* cbias = a.in[23]; const float* SB = WSP(float, WS_SB); bf16_t* Gb = WSP(bf16_t, WS_G);
        for (int task = bx * 512 + tid; task < 127 * 704; task += G * 512) {
            const int sl = task / 704, q = task % 704, ch = q * 4, r1 = 64 * (sl + 1);
            const int slen = (r1 < NCTX) ? 256 : 1024;
            if ((r1 & (slen - 1)) == 0) continue;
            f32x4 av[2][4];
#pragma unroll
            for (int bj = 0; bj < 2; ++bj) {
                av[bj][0] = __builtin_nontemporal_load((const f32x4*)(SB + ((size_t)(sl * 4 + 2) * 2 + bj) * DFF + ch)); av[bj][1] = __builtin_nontemporal_load((const f32x4*)(SB + ((size_t)(sl * 4 + 3) * 2 + bj) * DFF + ch));
                av[bj][2] = __builtin_nontemporal_load((const f32x4*)(SB + ((size_t)((sl + 1) * 4 + 0) * 2 + bj) * DFF + ch)); av[bj][3] = __builtin_nontemporal_load((const f32x4*)(SB + ((size_t)((sl + 1) * 4 + 1) * 2 + bj) * DFF + ch));
            }
            f32x4 o[2][2];
#pragma unroll
            for (int bj = 0; bj < 2; ++bj) { const float* wp = cw + bj * DFF + ch; const f32x4 w0 = *(const f32x4*)wp, w1 = *(const f32x4*)(wp + DFF2), w2 = *(const f32x4*)(wp + 2 * DFF2), bb = *(const f32x4*)(cbias + bj * DFF + ch);
                o[bj][0] = bb + w0 * av[bj][0] + w1 * av[bj][1] + w2 * av[bj][2]; o[bj][1] = bb + w0 * av[bj][1] + w1 * av[bj][2] + w2 * av[bj][3]; }
#pragma unroll
            for (int rr = 0; rr < 2; ++rr) { const f32x4 gt = o[0][rr], vl = o[1][rr]; u32x2 w;
                w.x = cvt_pk_bf16(gt[0] / (1.f + __expf(-gt[0])) * vl[0], gt[1] / (1.f + __expf(-gt[1])) * vl[1]);
                w.y = cvt_pk_bf16(gt[2] / (1.f + __expf(-gt[2])) * vl[2], gt[3] / (1.f + __expf(-gt[3])) * vl[3]);
                *(u32x2*)(Gb + (size_t)(r1 - 1 + rr) * DFF + ch) = w; }
        }
    }
    SEAM(8);
    PH(9) {
        pg8::Gemm g{WSP(bf16_t, WS_G), WSP(bf16_t, WS_WTDN), NTOK, D, DFF / 2, DFF, DFF}; SplitOrder S; S.init(NTOK, D, DFF / 2, G, bx);
        EpiF32 E{WSP(bf16_t, WS_P0), WSP(bf16_t, WS_P1)};
        pg8::gemm_phase<EpiF32, SplitOrder, true, true>(lds, g, S, E);
    }
    SEAM(9);
    PH(10) {
        const int col = 4 * lane, row0 = gw, row1 = gw + ngw;
        const f32x4 gg = *(const f32x4*)(a.in[12] + col);
        const float s0 = sum8(WSP(float, WS_SSQ1) + (size_t)row0 * SSQS + 12), s1 = sum8(WSP(float, WS_SSQ1) + (size_t)row1 * SSQS + 12);
        const f32x4 r0v = __builtin_nontemporal_load((const f32x4*)(WSP(float, WS_KVRAW) + (size_t)row0 * 256 + col)), r1v = __builtin_nontemporal_load((const f32x4*)(WSP(float, WS_KVRAW) + (size_t)row1 * 256 + col));
        rows_final(WSP(bf16_t, WS_X1), WSP(bf16_t, WS_P0), WSP(bf16_t, WS_P1), WSP(float, WS_MODS), a.in[25], out_y, gw, ngw, lane);
        *(f32x4*)(out_ckv + (size_t)row0 * 256 + col) = r0v * (1.0f / sqrtf(s0 * (1.f / 256.f) + EPS)) * gg;
        *(f32x4*)(out_ckv + (size_t)row1 * 256 + col) = r1v * (1.0f / sqrtf(s1 * (1.f / 256.f) + EPS)) * gg;
    }
#undef IN
#undef SEAM
}

extern "C" void kernel_launch(void* const* d_in, const int* in_sizes, int n_in, void* d_out, int out_size, void* d_ws, size_t ws_size, hipStream_t stream) {
    static int grid = 0;
    if (grid == 0) {
        if (n_in != 26 || ws_size < WS_END) { fprintf(stderr, "kernel_launch: unexpected n_in %d / ws %zu\n", n_in, ws_size); grid = -1; return; }
        int dev = 0, cus = 0, per_cu = 0;
        (void)hipGetDevice(&dev); (void)hipDeviceGetAttribute(&cus, hipDeviceAttributeMultiprocessorCount, dev);
        if (hipFuncSetAttribute((const void*)mk_fwd, hipFuncAttributeMaxDynamicSharedMemorySize, LDS_BYTES) != hipSuccess) { fprintf(stderr, "kernel_launch: hipFuncSetAttribute failed\n"); grid = -1; return; }
        if (hipOccupancyMaxActiveBlocksPerMultiprocessor(&per_cu, (const void*)mk_fwd, 512, LDS_BYTES) != hipSuccess || per_cu < 1) { fprintf(stderr, "kernel_launch: occupancy query says %d\n", per_cu); per_cu = 1; }
        (void)hipGetLastError();
        grid = cus * 1;
        if (grid != 256) { fprintf(stderr, "kernel_launch: this kernel is laid out for 256 CUs, found %d\n", grid); grid = -1; return; }
    }
    if (grid < 0) return;
    (void)hipMemsetAsync((char*)d_ws + WS_CTL, 0, CTL_BYTES, stream);
    Args a{};
    for (int i = 0; i < 26; ++i) a.in[i] = (const float*)d_in[i];
    a.out = (float*)d_out; a.ws = (unsigned char*)d_ws;
#if MK_ONE_LAUNCH
    a.ph_lo = 0; a.ph_hi = NPH;
    void* args[] = {&a};
    hipError_t e = hipLaunchCooperativeKernel((const void*)mk_fwd, dim3(grid), dim3(512), args, LDS_BYTES, stream);
    if (e != hipSuccess) fprintf(stderr, "cooperative launch failed: %s (grid %d)\n", hipGetErrorString(e), grid);
#else
    for (int p = 0; p < NPH; ++p) { a.ph_lo = p; a.ph_hi = p + 1; for (int r = 0; r < 1 + ((MK_REP >> p) & 1) * MK_REPN; ++r) hipLaunchKernelGGL(mk_fwd, dim3(grid), dim3(512), LDS_BYTES, stream, a); }
#endif
}
```

```cpp
#include <hip/hip_runtime.h>
#include <hip/hip_cooperative_groups.h>
#include <cstdio>
#include <cstdint>
namespace cg = cooperative_groups;
#ifndef PG8_TS
#define PG8_TS(id, begin) do { } while (0)
#endif
namespace pg8 {
#define PG8_LAS __attribute__((address_space(3)))
typedef unsigned short bf16_t;
typedef short bf16x8 __attribute__((ext_vector_type(8)));
typedef float f32x4 __attribute__((ext_vector_type(4)));
typedef unsigned u32x4 __attribute__((ext_vector_type(4)));
constexpr int BM = 256, BK = 64, HALF = 128, HTB = HALF * BK * 2  , STAGE_BYTES = 8 * HTB, NXCD = 8, WGM = 4;

__host__ __device__ __forceinline__ int lds_byte(int r, int c) { const int st = (r >> 4) * 2 + (c >> 5), rr = r & 15, cc = c & 31, ob = rr * 64 + cc * 2; return st * 1024 + (ob ^ (((ob >> 9) & 1) << 5)); }
__host__ __device__ __forceinline__ void stage_rc(int b, int& R, int& C) { const int st = b / 1024, sb = b % 1024, swz = sb ^ (((sb >> 9) & 1) << 5); R = (st >> 1) * 16 + swz / 64; C = (st & 1) * 32 + (swz % 64) / 2; }
__host__ __device__ __forceinline__ int perm32(int rho) { const int n = rho >> 4, i = rho & 15; return 8 * (i >> 2) + 4 * n + (i & 3); }

struct Unit { int pm, pn, koff; };
struct Gemm { const bf16_t* A; const bf16_t* Bt; int M, N, K, lda, ldb; };

struct StaticOrder {
    int nM, nN, nwg, G, c;
    __host__ __device__ void init(int M, int N, int G_, int c_) { nM = M / BM; nN = N / BM; nwg = nM * nN; G = G_; c = c_; }
    __host__ __device__ bool next(int i, Unit& u) const {
        const long L = (long)i * G + c; if (L >= nwg) return false;
        int wgid = (int)L; { const int q = nwg / NXCD, r = nwg % NXCD, xcd = wgid % NXCD, off = wgid / NXCD; wgid = (xcd < r ? xcd * (q + 1) : r * (q + 1) + (xcd - r) * q) + off; }
        const int nig = WGM * nN, gid = wgid / nig, fm = gid * WGM, gsz = (nM - fm) < WGM ? (nM - fm) : WGM;
        u.pm = fm + ((wgid % nig) % gsz); u.pn = (wgid % nig) / gsz; u.koff = 0; return true;
    }
    __device__ __forceinline__ void a_ready(const Unit&) const {}
    __device__ __forceinline__ void done(const Unit&) const {}
};

__device__ __forceinline__ unsigned cvt_pk_bf16(float lo, float hi) { unsigned r; asm volatile("v_cvt_pk_bf16_f32 %0, %1, %2" : "=v"(r) : "v"(lo), "v"(hi)); return r; }
typedef float f32x2 __attribute__((ext_vector_type(2)));
__device__ __forceinline__ f32x2 gelu_pk(f32x2 v) {
    const f32x2 av = __builtin_elementwise_abs(v), d = av * 0.2316418882f + 1.0f;
    f32x2 t; t.x = __builtin_amdgcn_rcpf(d.x); t.y = __builtin_amdgcn_rcpf(d.y);
    f32x2 q = t * 0.5307027145f + (-0.7265760135f); q = q * t + 0.7107068705f; q = q * t + (-0.142248368f); q = q * t + 0.127414796f; q = q * t;
    const f32x2 s = (v * v) * (-0.72134752044f);
    f32x2 e; e.x = __builtin_amdgcn_exp2f(s.x); e.y = __builtin_amdgcn_exp2f(s.y);
    const f32x2 m = v * (q * e), r = v - m;
    f32x2 o; o.x = v.x < 0.f ? m.x : r.x; o.y = v.y < 0.f ? m.y : r.y; return o;
}
template <class Epi, class Sched, bool ALIGN_EPI = false, bool SP2 = false>
__device__ __forceinline__ void gemm_phase(PG8_LAS unsigned char* lds, const Gemm g, const Sched& S, const Epi& E) {
    const int tid = threadIdx.x, wid = __builtin_amdgcn_readfirstlane(tid >> 6), lane = tid & 63, wr = wid >> 2, wc = wid & 3, fr = lane & 15, fq = lane >> 4;
    const int K = g.K, nt = K / BK;
    unsigned voffA[2], voffB[2];
#pragma unroll
    for (int i = 0; i < 2; ++i) { int R, C; stage_rc(tid * 16 + i * 8192, R, C); const int Rb = Epi::PERM ? ((R & ~31) + perm32(R & 31)) : R;
        voffA[i] = (unsigned)(R * g.lda + C) * 2u; voffB[i] = (unsigned)(Rb * g.ldb + C) * 2u; }
    const size_t kstep = (size_t)(BK * 2);
    const size_t hstepA = (size_t)HALF * g.lda * 2, hstepB = (size_t)HALF * g.ldb * 2;
    const size_t tstepA = 2 * hstepA, tstepB = 2 * hstepB;
    const unsigned ldsw = (unsigned)wid * 1024u;
    const int aoff = lds_byte(wr * 64 + fr, fq * 8), boff = lds_byte(wc * 32 + fr, fq * 8);
#define PG8_SA(b, h) (((b) * 2 + (h)) * HTB)
#define PG8_SB(b, h) ((4 + (b) * 2 + (h)) * HTB)
#define PG8_STAGE(bufoff, gbase, voff) do { _Pragma("unroll") for (int _i = 0; _i < 2; ++_i) \
        __builtin_amdgcn_global_load_lds((const unsigned*)((const char*)(gbase) + (voff)[_i]), (PG8_LAS unsigned*)(lds + (bufoff) + ldsw + _i * 8192), 16, 0, 0); } while (0)
#define PG8_LDA(dst, b, h) do { _Pragma("unroll") for (int m = 0; m < 4; ++m) _Pragma("unroll") for (int k = 0; k < 2; ++k) dst[m][k] = *(const PG8_LAS bf16x8*)(lds + PG8_SA(b, h) + aoff + m * 2048 + k * 1024); } while (0)
#define PG8_LDB(dst, b, h) do { _Pragma("unroll") for (int n = 0; n < 2; ++n) _Pragma("unroll") for (int k = 0; k < 2; ++k) dst[n][k] = *(const PG8_LAS bf16x8*)(lds + PG8_SB(b, h) + boff + n * 2048 + k * 1024); } while (0)
#define PG8_MMA(ai, bj, At, Bt) do { __builtin_amdgcn_s_setprio(1); _Pragma("unroll") for (int m = 0; m < 4; ++m) _Pragma("unroll") for (int n = 0; n < 2; ++n) _Pragma("unroll") for (int k = 0; k < 2; ++k) \
        acc[ai][bj][m][n] = __builtin_amdgcn_mfma_f32_16x16x32_bf16(Bt[n][k], At[m][k], acc[ai][bj][m][n], 0, 0, 0); __builtin_amdgcn_s_setprio(0); } while (0)
#define PG8_WAIT_V(n) asm volatile("s_waitcnt vmcnt(" #n ")" ::: "memory")
#define PG8_WAIT_L(n) asm volatile("s_waitcnt lgkmcnt(" #n ")" ::: "memory")
#define PG8_BAR __builtin_amdgcn_s_barrier()
#define PG8_SCHED __builtin_amdgcn_sched_barrier(0)
    Unit cur, nxt; int ui = 0;
    if (!S.next(0, cur)) return;
    f32x4 acc[2][2][4][2];
#pragma unroll
    for (int a = 0; a < 2; ++a)
#pragma unroll
        for (int b = 0; b < 2; ++b)
#pragma unroll
            for (int m = 0; m < 4; ++m)
#pragma unroll
                for (int n = 0; n < 2; ++n) acc[a][b][m][n] = (f32x4){0.f, 0.f, 0.f, 0.f};
    bf16x8 At[4][2], B0[2][2], B1[2][2];
    const char* cA = (const char*)g.A + (size_t)cur.pm * tstepA + (size_t)cur.koff * 2; const char* cB = (const char*)g.Bt + (size_t)cur.pn * tstepB + (size_t)cur.koff * 2;
    S.a_ready(cur);
    if constexpr (SP2) {
        PG8_STAGE(PG8_SB(0, 0), cB, voffB); PG8_STAGE(PG8_SB(0, 1), cB + hstepB, voffB); PG8_STAGE(PG8_SA(0, 0), cA, voffA); PG8_STAGE(PG8_SA(0, 1), cA + hstepA, voffA);
        if (wr == 1) PG8_BAR;
        PG8_WAIT_V(2); PG8_BAR;
        PG8_STAGE(PG8_SB(1, 0), cB + kstep, voffB); PG8_STAGE(PG8_SA(1, 0), cA + kstep, voffA); PG8_STAGE(PG8_SB(1, 1), cB + hstepB + kstep, voffB);
        PG8_WAIT_V(6); PG8_BAR;
    } else {
        PG8_STAGE(PG8_SB(0, 0), cB, voffB); PG8_STAGE(PG8_SA(0, 0), cA, voffA); PG8_STAGE(PG8_SB(0, 1), cB + hstepB, voffB); PG8_STAGE(PG8_SA(0, 1), cA + hstepA, voffA);
        if (wr == 1) PG8_BAR;
        PG8_WAIT_V(4); PG8_BAR;
        PG8_STAGE(PG8_SB(1, 0), cB + kstep, voffB); PG8_STAGE(PG8_SA(1, 0), cA + kstep, voffA); PG8_STAGE(PG8_SB(1, 1), cB + hstepB + kstep, voffB);
        PG8_WAIT_V(6); PG8_BAR;
    }
    for (;;) {
        const bool has_next = S.next(ui + 1, nxt);
        const char* nA = has_next ? (const char*)g.A + (size_t)nxt.pm * tstepA + (size_t)nxt.koff * 2 : cA; const char* nB = has_next ? (const char*)g.Bt + (size_t)nxt.pn * tstepB + (size_t)nxt.koff * 2 : cB;
#pragma clang loop unroll(disable)
        for (int t = 0; t < nt; t += 2) {
            const bool last = (t == nt - 2);
            const char* a1 = cA + (size_t)(t + 1) * kstep;
            const char* a2 = last ? nA : cA + (size_t)(t + 2) * kstep; const char* b2 = last ? nB : cB + (size_t)(t + 2) * kstep;
            const char* a3 = a2 + kstep; const char* b3 = b2 + kstep;
            if (last && has_next) S.a_ready(nxt);
            if constexpr (SP2) {
            PG8_LDB(B0, 0, 0); PG8_LDB(B1, 0, 1); PG8_SCHED; PG8_LDA(At, 0, 0); PG8_STAGE(PG8_SA(1, 1), a1 + hstepA, voffA);
            PG8_WAIT_V(8); PG8_WAIT_L(0); PG8_BAR; PG8_MMA(0, 0, At, B0); PG8_MMA(0, 1, At, B1); PG8_BAR; PG8_SCHED;
            PG8_LDA(At, 0, 1); PG8_STAGE(PG8_SB(0, 0), b2, voffB); PG8_STAGE(PG8_SB(0, 1), b2 + hstepB, voffB); PG8_STAGE(PG8_SA(0, 0), a2, voffA);
            PG8_WAIT_V(8); PG8_WAIT_L(0); PG8_BAR; PG8_MMA(1, 0, At, B0); PG8_MMA(1, 1, At, B1); PG8_BAR; PG8_SCHED;
            PG8_LDB(B0, 1, 0); PG8_LDB(B1, 1, 1); PG8_SCHED; PG8_LDA(At, 1, 0); PG8_STAGE(PG8_SA(0, 1), a2 + hstepA, voffA);
            PG8_WAIT_V(8); PG8_WAIT_L(0); PG8_BAR; PG8_MMA(0, 0, At, B0); PG8_MMA(0, 1, At, B1); PG8_BAR; PG8_SCHED;
            PG8_LDA(At, 1, 1); PG8_STAGE(PG8_SB(1, 0), b3, voffB); PG8_STAGE(PG8_SB(1, 1), b3 + hstepB, voffB); PG8_STAGE(PG8_SA(1, 0), a3, voffA);
            PG8_WAIT_V(8); PG8_WAIT_L(0); PG8_BAR; PG8_MMA(1, 0, At, B0); PG8_MMA(1, 1, At, B1); PG8_BAR; PG8_SCHED;
            } else {
            PG8_LDB(B0, 0, 0); PG8_SCHED; PG8_LDA(At, 0, 0); PG8_STAGE(PG8_SA(1, 1), a1 + hstepA, voffA);
            PG8_WAIT_L(8); PG8_BAR; PG8_WAIT_L(0); PG8_MMA(0, 0, At, B0); PG8_BAR; PG8_SCHED;
            PG8_LDB(B1, 0, 1); PG8_STAGE(PG8_SB(0, 0), b2, voffB);
            PG8_BAR; PG8_WAIT_L(0); PG8_MMA(0, 1, At, B1); PG8_BAR;
            PG8_LDA(At, 0, 1); PG8_STAGE(PG8_SA(0, 0), a2, voffA);
            PG8_BAR; PG8_WAIT_L(0); PG8_MMA(1, 0, At, B0); PG8_BAR; PG8_SCHED;
            PG8_STAGE(PG8_SB(0, 1), b2 + hstepB, voffB);
            PG8_WAIT_V(6); PG8_BAR; PG8_MMA(1, 1, At, B1); PG8_BAR;
            PG8_LDB(B0, 1, 0); PG8_SCHED; PG8_LDA(At, 1, 0); PG8_STAGE(PG8_SA(0, 1), a2 + hstepA, voffA);
            PG8_WAIT_L(8); PG8_BAR; PG8_WAIT_L(0); PG8_MMA(0, 0, At, B0); PG8_BAR; PG8_SCHED;
            PG8_LDB(B1, 1, 1); PG8_STAGE(PG8_SB(1, 0), b3, voffB);
            PG8_BAR; PG8_WAIT_L(0); PG8_MMA(0, 1, At, B1); PG8_BAR;
            PG8_LDA(At, 1, 1); PG8_STAGE(PG8_SA(1, 0), a3, voffA);
            PG8_BAR; PG8_WAIT_L(0); PG8_MMA(1, 0, At, B0); PG8_BAR; PG8_SCHED;
            PG8_STAGE(PG8_SB(1, 1), b3 + hstepB, voffB);
            PG8_WAIT_V(6); PG8_BAR; PG8_MMA(1, 1, At, B1); PG8_BAR;
            }
        }
        if constexpr (ALIGN_EPI) { if (wr == 0) PG8_BAR; }
        if constexpr (!Epi::AFTER_DRAIN) { E(acc, cur, wr, wc, fr, fq); S.done(cur); }
        if (!has_next) break;
#pragma unroll
        for (int a = 0; a < 2; ++a)
#pragma unroll
            for (int b = 0; b < 2; ++b)
#pragma unroll
                for (int m = 0; m < 4; ++m)
#pragma unroll
                    for (int n = 0; n < 2; ++n) acc[a][b][m][n] = (f32x4){0.f, 0.f, 0.f, 0.f};
        cur = nxt; cA = nA; cB = nB; ++ui;
        if constexpr (ALIGN_EPI) { if (wr == 1) PG8_BAR; }
    }
    PG8_WAIT_V(0);
    if constexpr (!ALIGN_EPI) { if (wr == 0) PG8_BAR; }
    PG8_BAR;
    if constexpr (Epi::AFTER_DRAIN) { E.fused(acc, cur, wr, wc, fr, fq, lds, wid, lane); S.done(cur); }
#undef PG8_SA
#undef PG8_SB
#undef PG8_STAGE
#undef PG8_LDA
#undef PG8_LDB
#undef PG8_MMA
#undef PG8_WAIT_V
#undef PG8_WAIT_L
#undef PG8_BAR
#undef PG8_SCHED
}
}

using pg8::bf16_t; using pg8::bf16x8; using pg8::f32x4; using pg8::u32x4; using pg8::Unit; using pg8::cvt_pk_bf16; using pg8::gelu_pk; using pg8::f32x2;
#define LAS __attribute__((address_space(3)))
typedef float f32x16 __attribute__((ext_vector_type(16)));
typedef unsigned u32x2 __attribute__((ext_vector_type(2)));

#ifndef MK_REP
#define MK_REP 0
#endif
#ifndef MK_REPN
#define MK_REPN 1
#endif
#ifndef DUPP0
#define DUPP0 1
#endif
#ifndef DUPP1
#define DUPP1 1
#endif
#ifndef DUPP2
#define DUPP2 1
#endif
#ifndef DUPP3
#define DUPP3 1
#endif
#ifndef DUPP4
#define DUPP4 1
#endif
#ifndef DUPP5
#define DUPP5 1
#endif
#ifndef DUPP6
#define DUPP6 1
#endif
#ifndef DUPP7
#define DUPP7 1
#endif
#ifndef DUPP8
#define DUPP8 1
#endif
#ifndef DUPP9
#define DUPP9 1
#endif
#ifndef DUPP10
#define DUPP10 1
#endif
#ifndef DUP_P0C
#define DUP_P0C 1
#endif
#ifndef DUP_ATT
#define DUP_ATT 1
#endif
#ifndef DUP_SPA
#define DUP_SPA 1
#endif
#ifndef DUP_E1V
#define DUP_E1V 1
#endif
#ifndef DUP_P0T
#define DUP_P0T 1
#endif
#ifndef DUP_P0G
#define DUP_P0G 1
#endif
#ifndef DUP_EC
#define DUP_EC 1
#endif
#ifndef DUP_E1U
#define DUP_E1U 1
#endif
#ifndef MK_ONE_LAUNCH
#define MK_ONE_LAUNCH 1
#endif

constexpr int D = 1024, NTOK = 8192, NCTX = 4096, NKEY = 10240, INW = 1696, INP = 1792, DFF = 2816, DFF2 = 5632;
constexpr int SSQS = 36;
constexpr float EPS = 1e-6f;
constexpr float QSCALE = 0.10206207261596575f * 1.4426950408889634f;
constexpr int NPH = 11;
constexpr size_t MiB = (size_t)1 << 20;
constexpr size_t WS_WT1 = 0, WS_WTQ = 4 * MiB, WS_WTKV = 5 * MiB, WS_WTO = 6 * MiB, WS_WTUP = 8 * MiB, WS_WTDN = 19 * MiB, WS_MODS = 25 * MiB,
                 WS_SSQ1 = 26 * MiB, WS_ROPE = 28 * MiB, WS_SSQA = 30 * MiB, WS_KR = 31 * MiB, WS_KVRAW = 32 * MiB, WS_H = 36 * MiB,
                 WS_QLAT = 64 * MiB, WS_KVA = 70 * MiB, WS_GVT = 75 * MiB, WS_GU = 83 * MiB, WS_Q = 91 * MiB, WS_KN = 103 * MiB, WS_VT = 113 * MiB,
                 WS_SSQG = 29 * MiB, WS_CTL = 52 * MiB, WS_MIX = 139 * MiB, WS_AUP = 64 * MiB, WS_X1 = 160 * MiB, WS_G = 192 * MiB, WS_PA = 192 * MiB, WS_PG = 208 * MiB, WS_P0 = 64 * MiB, WS_P1 = 80 * MiB, WS_SB = 128 * MiB, WS_END = 236 * MiB;
constexpr int CTL_BYTES = 16384;
constexpr int LDS_BYTES = 147456;

struct Args { const float* in[26]; float* out; unsigned char* ws; int ph_lo, ph_hi; };

__device__ __forceinline__ unsigned f2bf(float f) { unsigned u = __float_as_uint(f); return (u + 0x7fffu + ((u >> 16) & 1u)) >> 16; }
__device__ __forceinline__ float bf2f(unsigned short b) { return __uint_as_float((unsigned)b << 16); }
__device__ __forceinline__ float wave_sum(float v) {
#pragma unroll
    for (int o = 1; o < 64; o <<= 1) v += __shfl_xor(v, o);
    return v;
}
__device__ __forceinline__ u32x4 pack8(f32x4 a, f32x4 b) { u32x4 w; w.x = cvt_pk_bf16(a[0], a[1]); w.y = cvt_pk_bf16(a[2], a[3]); w.z = cvt_pk_bf16(b[0], b[1]); w.w = cvt_pk_bf16(b[2], b[3]); return w; }
__device__ __forceinline__ f32x4 gelu4(f32x4 v) { f32x2 a = gelu_pk((f32x2){v[0], v[1]}), b = gelu_pk((f32x2){v[2], v[3]}); return (f32x4){a.x, a.y, b.x, b.y}; }
__device__ __forceinline__ float dot4(f32x4 a) { return (a[0] * a[0] + a[1] * a[1]) + (a[2] * a[2] + a[3] * a[3]); }
__device__ __forceinline__ int mod_of_row(int row) { return row < NCTX ? 0 : 1 + ((row - NCTX) >> 10); }
__device__ __forceinline__ void rope8(f32x4& v0, f32x4& v1, float pos, int fq) {
    const float sg = (fq & 1) ? 1.f : -1.f;
    const float kf[8] = {0.15915494309189535f, 0.05032921210448704f, 0.015915494309189534f, 0.005032921210448704f, 0.0015915494309189536f, 0.0005032921210448704f, 0.00015915494309189535f, 0.00005032921210448704f};
#pragma unroll
    for (int e = 0; e < 4; ++e) {
        const float o0 = __shfl_xor(v0[e], 16), o1 = __shfl_xor(v1[e], 16);
        const float r0 = pos * kf[e], r1 = pos * kf[e + 4];
        const float c0 = __builtin_amdgcn_cosf(r0), s0 = __builtin_amdgcn_sinf(r0), c1 = __builtin_amdgcn_cosf(r1), s1 = __builtin_amdgcn_sinf(r1);
        v0[e] = v0[e] * c0 + sg * o0 * s0; v1[e] = v1[e] * c1 + sg * o1 * s1;
    }
}

struct Epi1 {
    static constexpr bool PERM = true, AFTER_DRAIN = false;
    bf16_t* qlat; bf16_t* kva; float* kvraw; bf16_t* gvt; bf16_t* gu; bf16_t* kr; float* ssq; float* out_krope; const float* qg; const float* kvg; const float* rope;
    __device__ __forceinline__ void operator()(const f32x4 (&acc)[2][2][4][2], const Unit& u, int wr, int wc, int fr, int fq) const {
        const int cl = wc * 32 + fq * 8;
#pragma unroll
        for (int bj = 0; bj < 2; ++bj) {
            const int hc = u.pn * 2 + bj;
            if (hc < 5) {
                const bool isq = hc < 3;
                const float* g = isq ? qg + hc * 128 + cl : kvg + (hc - 3) * 128 + cl;
                const f32x4 g0 = *(const f32x4*)g, g1 = *(const f32x4*)(g + 4);
#pragma unroll
                for (int ai = 0; ai < 2; ++ai)
#pragma unroll
                    for (int m = 0; m < 4; ++m) {
                        const int row = u.pm * 256 + ai * 128 + wr * 64 + m * 16 + fr;
                        const f32x4 v0 = acc[ai][bj][m][0], v1 = acc[ai][bj][m][1];
                        float s = dot4(v0) + dot4(v1); s += __shfl_xor(s, 16); s += __shfl_xor(s, 32);
                        if (fq == 0) ssq[(size_t)row * SSQS + hc * 4 + wc] = s;
                        if (!isq && row < NCTX) { float* p = kvraw + (size_t)row * 256 + (hc - 3) * 128 + cl; *(f32x4*)p = v0; *(f32x4*)(p + 4) = v1; }
                        const u32x4 w = pack8(v0 * g0, v1 * g1);
                        bf16_t* dst = isq ? qlat + (size_t)row * 384 + hc * 128 + cl : kva + (size_t)row * 256 + (hc - 3) * 128 + cl;
                        *(u32x4*)dst = w;
                    }
            } else if (hc < 13 && ((hc - 5) & 1) == 0) {
                const int gi = (hc - 5) >> 1;
                for (int dup = 0; dup < DUP_E1V; ++dup)
#pragma unroll
                for (int ai = 0; ai < 2; ++ai)
#pragma unroll
                    for (int m = 0; m < 4; ++m) {
                        const int row = u.pm * 256 + ai * 128 + wr * 64 + m * 16 + fr;
                        const f32x4 v0 = gelu4(acc[ai][bj][m][0]), v1 = gelu4(acc[ai][bj][m][1]);
                        float s = dot4(v0) + dot4(v1); s += __shfl_xor(s, 16); s += __shfl_xor(s, 32);
                        if (fq == 0) ssq[(size_t)row * SSQS + (5 + gi) * 4 + wc] = s;
                        bf16_t* dst = gvt + (size_t)(gi * 128 + cl) * NTOK + row;
#pragma unroll
                        for (int e = 0; e < 4; ++e) { dst[(size_t)e * NTOK] = (bf16_t)f2bf(v0[e]); dst[(size_t)(e + 4) * NTOK] = (bf16_t)f2bf(v1[e]); }
                    }
            } else if (hc < 13) {
                for (int dup = 0; dup < DUP_E1U; ++dup)
#pragma unroll
                for (int ai = 0; ai < 2; ++ai)
#pragma unroll
                    for (int m = 0; m < 4; ++m) {
                        const int row = u.pm * 256 + ai * 128 + wr * 64 + m * 16 + fr;
                        const f32x4 v0 = gelu4(acc[ai][bj][m][0]), v1 = gelu4(acc[ai][bj][m][1]);
                        *(u32x4*)(gu + (size_t)row * 512 + ((hc - 5) >> 1) * 128 + cl) = pack8(v0, v1);
                    }
            } else if (wc == 0) {
                const bool lat = u.pm >= 16;
#pragma unroll
                for (int ai = 0; ai < 2; ++ai)
#pragma unroll
                    for (int m = 0; m < 4; ++m) {
                        const int row = u.pm * 256 + ai * 128 + wr * 64 + m * 16 + fr;
                        f32x4 v0 = acc[ai][bj][m][0], v1 = acc[ai][bj][m][1];
                        int key = row;
                        if (lat) {
                            const int t = (row - NCTX) & 1023, b = (row - NCTX) >> 10;
                            key = NCTX + 1536 * b + 512 + t;
                            const int p = (fq < 2) ? (t >> 6) : (t & 63);
                            rope8(v0, v1, (float)p, fq);
                        } else { float* p = out_krope + (size_t)row * 32 + fq * 8; __builtin_nontemporal_store(v0, (f32x4*)p); __builtin_nontemporal_store(v1, (f32x4*)(p + 4)); }
                        *(u32x4*)(kr + (size_t)key * 32 + fq * 8) = pack8(v0, v1);
                    }
            }
        }
    }
};
struct Epi2 {
    static constexpr bool PERM = true, AFTER_DRAIN = false;
    bf16_t* q; const float* ssq; const float* rope;
    __device__ __forceinline__ void operator()(const f32x4 (&acc)[2][2][4][2], const Unit& u, int wr, int wc, int fr, int fq) const {
        const bool lat = u.pm >= 16;
#pragma unroll
        for (int ai = 0; ai < 2; ++ai) {
            float rsv[4];
#pragma unroll
            for (int m = 0; m < 4; ++m) {
                const f32x4* sp = (const f32x4*)(ssq + (size_t)(u.pm * 256 + ai * 128 + wr * 64 + m * 16 + fr) * SSQS);
                const f32x4 a = sp[0], b = sp[1], c = sp[2];
                rsv[m] = ((a[0] + a[1]) + (a[2] + a[3])) + ((b[0] + b[1]) + (b[2] + b[3])) + ((c[0] + c[1]) + (c[2] + c[3]));
            }
#pragma unroll
            for (int m = 0; m < 4; ++m) {
                const int row = u.pm * 256 + ai * 128 + wr * 64 + m * 16 + fr;
                const float rs = __builtin_amdgcn_rsqf(rsv[m] * (1.f / 384.f) + EPS) * QSCALE;
                const int t = (row - NCTX) & 1023;
#pragma unroll
                for (int bj = 0; bj < 2; ++bj) {
                    const int col0 = u.pn * 256 + bj * 128 + wc * 32;
                    f32x4 v0 = acc[ai][bj][m][0] * rs, v1 = acc[ai][bj][m][1] * rs;
                    if (lat && (col0 % 96) == 64) { const int p = (fq < 2) ? (t >> 6) : (t & 63); rope8(v0, v1, (float)p, fq); }
                    *(u32x4*)(q + (size_t)row * 768 + col0 + fq * 8) = pack8(v0, v1);
                }
                asm volatile("" ::: "memory");
            }
        }
    }
};
struct Epi3 {
    static constexpr bool PERM = true, AFTER_DRAIN = false;
    bf16_t* kn; bf16_t* vt; const float* ssq;
    __device__ __forceinline__ void operator()(const f32x4 (&acc)[2][2][4][2], const Unit& u, int wr, int wc, int fr, int fq) const {
#pragma unroll
        for (int ai = 0; ai < 2; ++ai) {
            float rsv[4];
#pragma unroll
            for (int m = 0; m < 4; ++m) {
                rsv[m] = 1.f;
                if (u.pm < 32) { const f32x4* sp = (const f32x4*)(ssq + (size_t)(u.pm * 256 + ai * 128 + wr * 64 + m * 16 + fr) * SSQS + 12);
                    const f32x4 a = sp[0], b = sp[1];
                    rsv[m] = __builtin_amdgcn_rsqf((((a[0] + a[1]) + (a[2] + a[3])) + ((b[0] + b[1]) + (b[2] + b[3]))) * (1.f / 256.f) + EPS); }
            }
#pragma unroll
            for (int m = 0; m < 4; ++m) {
                const int row = u.pm * 256 + ai * 128 + wr * 64 + m * 16 + fr;
                const float rs = rsv[m]; int key;
                if (u.pm < 32) key = (u.pm < 16) ? row : NCTX + 1536 * ((row - NCTX) >> 10) + 512 + ((row - NCTX) & 1023);
                else { const int j = row - NTOK; key = NCTX + 1536 * (j >> 9) + (j & 511); }
#pragma unroll
                for (int bj = 0; bj < 2; ++bj) {
                    const int h = u.pn * 2 + bj;
                    const f32x4 v0 = acc[ai][bj][m][0] * rs, v1 = acc[ai][bj][m][1] * rs;
                    if (wc < 2) *(u32x4*)(kn + ((size_t)h * NKEY + key) * 64 + wc * 32 + fq * 8) = pack8(v0, v1);
                    else { bf16_t* dst = vt + ((size_t)h * 64 + (wc - 2) * 32 + fq * 8) * NKEY + key;
#pragma unroll
                        for (int e = 0; e < 4; ++e) { dst[(size_t)e * NKEY] = (bf16_t)f2bf(v0[e]); dst[(size_t)(e + 4) * NKEY] = (bf16_t)f2bf(v1[e]); } }
                }
                asm volatile("" ::: "memory");
            }
        }
    }
};
struct EpiF32 {
    static constexpr bool PERM = true, AFTER_DRAIN = false;
    bf16_t* p0; bf16_t* p1;
    __device__ __forceinline__ void operator()(const f32x4 (&acc)[2][2][4][2], const Unit& u, int wr, int wc, int fr, int fq) const {
        bf16_t* out = u.koff ? p1 : p0;
#pragma unroll
        for (int ai = 0; ai < 2; ++ai)
#pragma unroll
            for (int m = 0; m < 4; ++m) {
                const int row = u.pm * 256 + ai * 128 + wr * 64 + m * 16 + fr;
#pragma unroll
                for (int bj = 0; bj < 2; ++bj) *(u32x4*)(out + (size_t)row * D + u.pn * 256 + bj * 128 + wc * 32 + fq * 8) = pack8(acc[ai][bj][m][0], acc[ai][bj][m][1]);
            }
    }
};
struct SplitOrder {
    pg8::StaticOrder so; int G, c, ksz;
    __device__ void init(int M, int N, int ksz_, int G_, int c_) { so.init(M, N, 1, 0); G = G_; c = c_; ksz = ksz_; }
    __device__ bool next(int i, Unit& u) const { const int L = i * G + c; if (L >= 2 * so.nwg) return false; const int sp = L / so.nwg; so.next(L - sp * so.nwg, u); u.koff = sp * ksz; return true; }
    __device__ __forceinline__ void a_ready(const Unit&) const {}
    __device__ __forceinline__ void done(const Unit&) const {}
};
struct EpiPlain {
    static constexpr bool PERM = true, AFTER_DRAIN = false;
    bf16_t* O; int ldc;
    __device__ __forceinline__ void operator()(const f32x4 (&acc)[2][2][4][2], const Unit& u, int wr, int wc, int fr, int fq) const {
#pragma unroll
        for (int ai = 0; ai < 2; ++ai)
#pragma unroll
            for (int m = 0; m < 4; ++m) {
                const int row = u.pm * 256 + ai * 128 + wr * 64 + m * 16 + fr;
#pragma unroll
                for (int bj = 0; bj < 2; ++bj)
                    *(u32x4*)(O + (size_t)row * ldc + u.pn * 256 + bj * 128 + wc * 32 + fq * 8) = pack8(acc[ai][bj][m][0], acc[ai][bj][m][1]);
            }
    }
};

__device__ __forceinline__ float dpp_ror1(float v) { return __builtin_bit_cast(float, __builtin_amdgcn_update_dpp(0, __builtin_bit_cast(int, v), 0x121, 0xf, 0xf, false)); }
__device__ __forceinline__ float dpp_ror15(float v) { return __builtin_bit_cast(float, __builtin_amdgcn_update_dpp(0, __builtin_bit_cast(int, v), 0x12F, 0xf, 0xf, false)); }
struct EpiConv {
    static constexpr bool PERM = true, AFTER_DRAIN = false;
    bf16_t* G; float* SB; const float* cw; const float* cb;
    __device__ __forceinline__ void operator()(const f32x4 (&acc)[2][2][4][2], const Unit& u, int wr, int wc, int fr, int fq) const {
        const int ch0 = u.pn * 128 + wc * 32 + fq * 8;
        for (int dup = 0; dup < DUP_EC; ++dup)
#pragma unroll
        for (int n = 0; n < 2; ++n) {
            const int ch = ch0 + 4 * n;
            f32x4 wg[3], wv[3];
#pragma unroll
            for (int k = 0; k < 3; ++k) { wg[k] = *(const f32x4*)(cw + k * DFF2 + ch); wv[k] = *(const f32x4*)(cw + k * DFF2 + DFF + ch); }
            const f32x4 bg = *(const f32x4*)(cb + ch), bv = *(const f32x4*)(cb + DFF + ch);
#pragma unroll
            for (int ai = 0; ai < 2; ++ai) {
                const int rb = u.pm * 256 + ai * 128 + wr * 64;
#pragma unroll
                for (int m = 0; m < 4; ++m) {
                    const int row = rb + m * 16 + fr;
                    f32x4 r[2];
#pragma unroll
                    for (int bj = 0; bj < 2; ++bj) {
                        const f32x4 cur = acc[ai][bj][m][n];
                        const f32x4 wk0 = bj ? wv[0] : wg[0], wk1 = bj ? wv[1] : wg[1], wk2 = bj ? wv[2] : wg[2], bb = bj ? bv : bg;
#pragma unroll
                        for (int e = 0; e < 4; ++e) {
                            const float up = (m > 0) ? acc[ai][bj][m > 0 ? m - 1 : 0][n][e] : 0.f, dn = (m < 3) ? acc[ai][bj][m < 3 ? m + 1 : 3][n][e] : 0.f;
                            const float prev = dpp_ror1(fr == 15 ? up : cur[e]), next = dpp_ror15(fr == 0 ? dn : cur[e]);
                            r[bj][e] = bb[e] + wk0[e] * prev + wk1[e] * cur[e] + wk2[e] * next;
                        }
                        if ((m == 0 && fr < 2) || (m == 3 && fr >= 14)) {
                            const int ridx = (m == 0) ? fr : fr - 12;
                            *(f32x4*)(SB + ((size_t)((rb >> 6) * 4 + ridx) * 2 + bj) * DFF + ch) = cur;
                        }
                    }
                    u32x2 w;
#define SILU_MUL(g_, v_) ((g_) * __builtin_amdgcn_rcpf(1.f + __builtin_amdgcn_exp2f(-1.4426950408889634f * (g_))) * (v_))
                    w.x = cvt_pk_bf16(SILU_MUL(r[0][0], r[1][0]), SILU_MUL(r[0][1], r[1][1]));
                    w.y = cvt_pk_bf16(SILU_MUL(r[0][2], r[1][2]), SILU_MUL(r[0][3], r[1][3]));
                    *(u32x2*)(G + (size_t)row * DFF + ch) = w;
                }
            }
        }
    }
};

struct TrItem { const float* W; bf16_t* WT; int N, K, src_n0, dst_n0, k0; };
__device__ __forceinline__ void tr_load(const TrItem& t, f32x4 (&v)[8], int lane) {
    const float* ub = t.W + (size_t)t.k0 * t.N + t.src_n0; const int lo_ = (lane >> 3) * t.N + 4 * (lane & 7);
#pragma unroll
    for (int i = 0; i < 8; ++i) v[i] = __builtin_nontemporal_load((const f32x4*)(ub + (size_t)(8 * i) * t.N + lo_));
}
__device__ __forceinline__ void tr_store(const TrItem& t, const f32x4 (&v)[8], LAS float* scr, int lane) {
#pragma unroll
    for (int i = 0; i < 8; ++i) { LAS float* d = scr + (8 * i + (lane >> 3)) * 33 + 4 * (lane & 7); d[0] = v[i][0]; d[1] = v[i][1]; d[2] = v[i][2]; d[3] = v[i][3]; }
    asm volatile("s_waitcnt lgkmcnt(0)" ::: "memory");
    const int c = lane & 7;
#pragma unroll
    for (int j = 0; j < 4; ++j) { const int n = (lane >> 3) + 8 * j; const LAS float* sp = scr + (8 * c) * 33 + n;
        u32x4 o; o.x = cvt_pk_bf16(sp[0 * 33], sp[1 * 33]); o.y = cvt_pk_bf16(sp[2 * 33], sp[3 * 33]); o.z = cvt_pk_bf16(sp[4 * 33], sp[5 * 33]); o.w = cvt_pk_bf16(sp[6 * 33], sp[7 * 33]);
        *(u32x4*)(t.WT + (size_t)(t.dst_n0 + n) * t.K + t.k0 + 8 * c) = o; }
    asm volatile("s_waitcnt lgkmcnt(0)" ::: "memory");
}
__device__ __forceinline__ int win_src_col(int j) { if (j < 640) return j; if (j >= 1664) return 640 + (j - 1664); const int h = (j - 640) >> 7, w = (j - 640) & 127; return (h & 1) ? 672 + (h >> 1) * 128 + w : 1184 + (h >> 1) * 128 + w; }

constexpr int TI1 = 16 * 53, TI2 = 6 * 24, TI3 = 4 * 32, TI4 = 16 * 32, TI5 = 16 * 176, TI6 = 44 * 32, TNIT = TI1 + TI2 + TI3 + TI4 + TI5 + TI6, TSPLIT = 2048;
__device__ __forceinline__ void transpose_items(const Args& a, unsigned char* ws, LAS float* scr, int first, int last, int w, int nw, int lane) {
#define TR_DECODE(t, it_) do { int r = (it_); \
        if (r < TI1) { const int kb = r / 53, nb = r % 53; t = TrItem{a.in[9], (bf16_t*)(ws + WS_WT1), INW, 1024, win_src_col(32 * nb), 32 * nb, 64 * kb}; } \
        else if ((r -= TI1) < TI2) { const int kb = r / 24, nb = r % 24; t = TrItem{a.in[11], (bf16_t*)(ws + WS_WTQ), 768, 384, 32 * nb, 32 * nb, 64 * kb}; } \
        else if ((r -= TI2) < TI3) { const int kb = r / 32, nb = r % 32; t = TrItem{a.in[13], (bf16_t*)(ws + WS_WTKV), 1024, 256, 32 * nb, 32 * nb, 64 * kb}; } \
        else if ((r -= TI3) < TI4) { const int kb = r / 32, nb = r % 32; t = TrItem{a.in[19], (bf16_t*)(ws + WS_WTO), 1024, 1024, 32 * nb, 32 * nb, 64 * kb}; } \
        else if ((r -= TI4) < TI5) { const int kb = r / 176, nb = r % 176; t = TrItem{a.in[21], (bf16_t*)(ws + WS_WTUP), DFF2, 1024, ((nb >> 2) & 1) * DFF + (nb >> 3) * 128 + (nb & 3) * 32, 32 * nb, 64 * kb}; } \
        else { r -= TI5; const int kb = r / 32, nb = r % 32; t = TrItem{a.in[24], (bf16_t*)(ws + WS_WTDN), 1024, DFF, 32 * nb, 32 * nb, 64 * kb}; } } while (0)
    for (int itb = first + w; itb < last; itb += 3 * nw) {
        const int it1 = itb + nw, it2 = itb + 2 * nw;
        TrItem t0, t1, t2; f32x4 va[8], vb[8];
        TR_DECODE(t0, itb); tr_load(t0, va, lane);
        if (it1 < last) { TR_DECODE(t1, it1); tr_load(t1, vb, lane); }
        tr_store(t0, va, scr, lane);
        if (it2 < last) { TR_DECODE(t2, it2); tr_load(t2, va, lane); }
        if (it1 < last) tr_store(t1, vb, scr, lane);
        if (it2 < last) tr_store(t2, va, scr, lane);
    }
#undef TR_DECODE
}

__device__ __forceinline__ void norm_rows(const float* src_lo, const float* src_hi, const float* g, const float* mods, int off_shift, int off_scale, bf16_t* dstb, int gw, int ngw, int lane) {
    for (int row0 = gw; row0 < NTOK; row0 += 4 * ngw) {
        f32x4 v[4][4];
#pragma unroll
        for (int p = 0; p < 4; ++p) { const int row = row0 + p * ngw; if (row < NTOK) { const float* xr = (row < NCTX ? src_lo : src_hi) + (size_t)row * D;
#pragma unroll
            for (int j = 0; j < 4; ++j) v[p][j] = __builtin_nontemporal_load((const f32x4*)(xr + 4 * lane + 256 * j)); } }
        f32x4 gg[4];
#pragma unroll
        for (int j = 0; j < 4; ++j) gg[j] = *(const f32x4*)(g + 4 * lane + 256 * j);
#pragma unroll
        for (int p = 0; p < 4; ++p) { const int row = row0 + p * ngw; if (row < NTOK) {
            const float* mp = mods + (size_t)mod_of_row(row) * 6144;
            f32x4 sh[4], sc[4];
#pragma unroll
            for (int j = 0; j < 4; ++j) { sh[j] = *(const f32x4*)(mp + off_shift + 4 * lane + 256 * j); sc[j] = *(const f32x4*)(mp + off_scale + 4 * lane + 256 * j); }
            float s = 0.f;
#pragma unroll
            for (int j = 0; j < 4; ++j) s += dot4(v[p][j]);
            const float rstd = 1.0f / sqrtf(wave_sum(s) * (1.f / D) + EPS);
#pragma unroll
            for (int j = 0; j < 4; ++j) { const int col = 4 * lane + 256 * j;
                const f32x4 o = v[p][j] * rstd * gg[j] * (sc[j] + 1.f) + sh[j];
                u32x2 w; w.x = cvt_pk_bf16(o[0], o[1]); w.y = cvt_pk_bf16(o[2], o[3]);
                *(u32x2*)(dstb + (size_t)row * D + col) = w; } } }
    }
}

constexpr int AT_KSTR = 208, AT_VSTR = 136, AT_KBYTES = 64 * AT_KSTR, AT_VBYTES = 64 * AT_VSTR, AT_BUF = AT_KBYTES + AT_VBYTES;
__device__ __forceinline__ void attn_unit(LAS unsigned char* lds, const bf16_t* Q, const bf16_t* KN, const bf16_t* KR, const bf16_t* VT, bf16_t* MIX, const float* og, float* SSQA,
                                          int qrow0, int head, int kbase, int nkeys) {
    const int tid = threadIdx.x, lane = tid & 63, wid = tid >> 6, r32 = lane & 31, hi = lane >> 5;
    const int qg = wid & 3, kh = wid >> 2, ht = tid & 255;
    const int qrow = qrow0 + qg * 32 + r32;
    bf16x8 qf[6];
    { const bf16_t* qp = Q + (size_t)qrow * 768 + head * 96 + hi * 8;
#pragma unroll
      for (int d0 = 0; d0 < 6; ++d0) qf[d0] = __builtin_nontemporal_load((const bf16x8*)(qp + d0 * 16)); }
    const int nk2 = nkeys >> 1, k0 = kbase + kh * nk2, NT = nk2 >> 6;
    const bf16_t* knp = KN + ((size_t)head * NKEY + k0) * 64;
    const bf16_t* krp = KR + (size_t)k0 * 32;
    const bf16_t* vtp = VT + (size_t)head * 64 * NKEY + k0;
    u32x4 gA[5], gB[5];
#define AT_LOAD(R, t) do { const int kk = (t) * 64; \
        R[0] = *(const u32x4*)(knp + (size_t)(kk + (ht >> 3)) * 64 + (ht & 7) * 8); R[1] = *(const u32x4*)(knp + (size_t)(kk + 32 + (ht >> 3)) * 64 + (ht & 7) * 8); \
        R[2] = *(const u32x4*)(krp + (size_t)(kk + (ht >> 2)) * 32 + (ht & 3) * 8); \
        R[3] = *(const u32x4*)(vtp + (size_t)(ht >> 3) * NKEY + kk + (ht & 7) * 8); R[4] = *(const u32x4*)(vtp + (size_t)(32 + (ht >> 3)) * NKEY + kk + (ht & 7) * 8); } while (0)
#define AT_STORE(R, b) do { LAS unsigned char* kb_ = lds + (kh * 2 + (b)) * AT_BUF; LAS unsigned char* vb_ = kb_ + AT_KBYTES; \
        *(LAS u32x4*)(kb_ + (ht >> 3) * AT_KSTR + (ht & 7) * 16) = R[0]; *(LAS u32x4*)(kb_ + (32 + (ht >> 3)) * AT_KSTR + (ht & 7) * 16) = R[1]; \
        *(LAS u32x4*)(kb_ + (ht >> 2) * AT_KSTR + 128 + (ht & 3) * 16) = R[2]; \
        *(LAS u32x2*)(vb_ + (ht >> 3) * AT_VSTR + (ht & 7) * 16) = (u32x2){R[3].x, R[3].y}; *(LAS u32x2*)(vb_ + (ht >> 3) * AT_VSTR + (ht & 7) * 16 + 8) = (u32x2){R[3].z, R[3].w}; \
        *(LAS u32x2*)(vb_ + (32 + (ht >> 3)) * AT_VSTR + (ht & 7) * 16) = (u32x2){R[4].x, R[4].y}; *(LAS u32x2*)(vb_ + (32 + (ht >> 3)) * AT_VSTR + (ht & 7) * 16 + 8) = (u32x2){R[4].z, R[4].w}; } while (0)
    float m_run = 0.f, l_run = 0.f;
    f32x16 o0, o1, negm;
#pragma unroll
    for (int r = 0; r < 16; ++r) { o0[r] = 0.f; o1[r] = 0.f; negm[r] = 0.f; }
#define AT_COMPUTE(b, first) do { \
        const LAS unsigned char* kb = lds + (kh * 2 + (b)) * AT_BUF; const LAS unsigned char* vb = kb + AT_KBYTES; \
        f32x16 s0, s1; \
        _Pragma("unroll") for (int d0 = 0; d0 < 6; ++d0) { \
            const bf16x8 k0f = *(const LAS bf16x8*)(kb + r32 * AT_KSTR + d0 * 32 + hi * 16); \
            const bf16x8 k1f = *(const LAS bf16x8*)(kb + (32 + r32) * AT_KSTR + d0 * 32 + hi * 16); \
            if (d0 == 0) { s0 = __builtin_amdgcn_mfma_f32_32x32x16_bf16(k0f, qf[0], negm, 0, 0, 0); s1 = __builtin_amdgcn_mfma_f32_32x32x16_bf16(k1f, qf[0], negm, 0, 0, 0); } \
            else { s0 = __builtin_amdgcn_mfma_f32_32x32x16_bf16(k0f, qf[d0], s0, 0, 0, 0); s1 = __builtin_amdgcn_mfma_f32_32x32x16_bf16(k1f, qf[d0], s1, 0, 0, 0); } } \
        float mx = fmaxf(s0[0], s1[0]); \
        _Pragma("unroll") for (int r = 1; r < 16; ++r) mx = fmaxf(mx, fmaxf(s0[r], s1[r])); \
        mx = fmaxf(mx, __shfl_xor(mx, 32)); \
        if ((first) || __any(mx > 8.0f)) { \
            const float dl = (first) ? mx : fmaxf(mx, 0.f), alpha = (first) ? 0.f : __builtin_amdgcn_exp2f(-dl); \
            m_run += dl; l_run *= alpha; \
            _Pragma("unroll") for (int r = 0; r < 16; ++r) { s0[r] -= dl; s1[r] -= dl; o0[r] *= alpha; o1[r] *= alpha; negm[r] = -m_run; } } \
        float ls = 0.f; \
        _Pragma("unroll") for (int r = 0; r < 16; ++r) { s0[r] = __builtin_amdgcn_exp2f(s0[r]); s1[r] = __builtin_amdgcn_exp2f(s1[r]); ls += s0[r] + s1[r]; } \
        l_run += ls; \
        u32x4 pb[4]; \
        pb[0] = pack8((f32x4){s0[0], s0[1], s0[2], s0[3]}, (f32x4){s0[4], s0[5], s0[6], s0[7]}); \
        pb[1] = pack8((f32x4){s0[8], s0[9], s0[10], s0[11]}, (f32x4){s0[12], s0[13], s0[14], s0[15]}); \
        pb[2] = pack8((f32x4){s1[0], s1[1], s1[2], s1[3]}, (f32x4){s1[4], s1[5], s1[6], s1[7]}); \
        pb[3] = pack8((f32x4){s1[8], s1[9], s1[10], s1[11]}, (f32x4){s1[12], s1[13], s1[14], s1[15]}); \
        _Pragma("unroll") for (int ks = 0; ks < 4; ++ks) { \
            const bf16x8 pf = __builtin_bit_cast(bf16x8, pb[ks]); \
            const LAS unsigned char* vp = vb + r32 * AT_VSTR + ks * 32 + hi * 8; \
            const u32x2 a0 = *(const LAS u32x2*)(vp), a1 = *(const LAS u32x2*)(vp + 16); \
            const u32x2 c0 = *(const LAS u32x2*)(vp + 32 * AT_VSTR), c1 = *(const LAS u32x2*)(vp + 32 * AT_VSTR + 16); \
            o0 = __builtin_amdgcn_mfma_f32_32x32x16_bf16(__builtin_bit_cast(bf16x8, (u32x4){a0.x, a0.y, a1.x, a1.y}), pf, o0, 0, 0, 0); \
            o1 = __builtin_amdgcn_mfma_f32_32x32x16_bf16(__builtin_bit_cast(bf16x8, (u32x4){c0.x, c0.y, c1.x, c1.y}), pf, o1, 0, 0, 0); } } while (0)
    AT_LOAD(gA, 0); AT_LOAD(gB, 1);
    for (int t = 0; t < NT; t += 2) {
        AT_STORE(gA, 0);
        __syncthreads();
        if (t + 2 < NT) AT_LOAD(gA, t + 2);
        AT_COMPUTE(0, t == 0);
        AT_STORE(gB, 1);
        __syncthreads();
        if (t + 3 < NT) AT_LOAD(gB, t + 3);
        AT_COMPUTE(1, false);
    }
#undef AT_LOAD
#undef AT_STORE
#undef AT_COMPUTE
    l_run += __shfl_xor(l_run, 32);
    __syncthreads();
    LAS float* cb = (LAS float*)lds + (qg * 64 + lane) * 35;
    if (kh == 1) {
        cb[0] = m_run; cb[1] = l_run;
#pragma unroll
        for (int r = 0; r < 16; ++r) { cb[2 + r] = o0[r]; cb[18 + r] = o1[r]; }
    }
    __syncthreads();
    if (kh == 0) {
        const float m1 = cb[0], l1 = cb[1];
        const float mn = fmaxf(m_run, m1), a0 = __builtin_amdgcn_exp2f(m_run - mn), a1 = __builtin_amdgcn_exp2f(m1 - mn);
        const float inv = 1.0f / (l_run * a0 + l1 * a1);
        float ss = 0.f;
#pragma unroll
        for (int r = 0; r < 16; ++r) { o0[r] = (o0[r] * a0 + cb[2 + r] * a1) * inv; o1[r] = (o1[r] * a0 + cb[18 + r] * a1) * inv; ss += o0[r] * o0[r] + o1[r] * o1[r]; }
        ss += __shfl_xor(ss, 32);
        bf16_t* op = MIX + (size_t)qrow * D + head * 64 + 4 * hi; const float* gp = og + head * 64 + 4 * hi;
#pragma unroll
        for (int g4 = 0; g4 < 4; ++g4) {
            const f32x4 ga = *(const f32x4*)(gp + 8 * g4), gb = *(const f32x4*)(gp + 32 + 8 * g4);
            u32x2 w; w.x = cvt_pk_bf16(o0[4 * g4] * ga[0], o0[4 * g4 + 1] * ga[1]); w.y = cvt_pk_bf16(o0[4 * g4 + 2] * ga[2], o0[4 * g4 + 3] * ga[3]);
            *(u32x2*)(op + 8 * g4) = w;
            w.x = cvt_pk_bf16(o1[4 * g4] * gb[0], o1[4 * g4 + 1] * gb[1]); w.y = cvt_pk_bf16(o1[4 * g4 + 2] * gb[2], o1[4 * g4 + 3] * gb[3]);
            *(u32x2*)(op + 32 + 8 * g4) = w;
        }
        if (hi == 0) SSQA[(size_t)qrow * 8 + head] = ss;
    }
    __syncthreads();
}

#define BFLO(w) __uint_as_float((w) << 16)
#define BFHI(w) __uint_as_float((w) & 0xffff0000u)
__device__ __forceinline__ void spatial_unit(LAS unsigned char* lds, int chunk, int g, const bf16_t* GVT, const bf16_t* GU, const float* SSQ1, const float* w_s, const float* b_s,
                                             const float* vg, const float* og, bf16_t* MIX, float* SSQG) {
    const int tid = threadIdx.x, lane = tid & 63, wid = tid >> 6, r32 = lane & 31, hi = lane >> 5;
    const int ih = wid & 3, ch = wid >> 2, t0 = chunk * 128, i = ih * 32 + r32;
    LAS float* rv = (LAS float*)lds;
    f32x4 pss = (f32x4){0.f, 0.f, 0.f, 0.f};
    if (tid < 128) pss = *(const f32x4*)(SSQ1 + (size_t)(t0 + tid) * SSQS + 20 + 4 * g);
    f32x4 wv[8][2]; bf16x8 af[2][8];
#pragma unroll
    for (int ks = 0; ks < 8; ++ks) { const float* wp = w_s + ((size_t)g * 128 + i) * 128 + 16 * ks + 8 * hi; wv[ks][0] = *(const f32x4*)wp; wv[ks][1] = *(const f32x4*)(wp + 4);
#pragma unroll
        for (int ct = 0; ct < 2; ++ct) af[ct][ks] = *(const bf16x8*)(GVT + (size_t)(g * 128 + ch * 64 + ct * 32 + r32) * NTOK + t0 + 16 * ks + 8 * hi); }
    const float bs = b_s[g * 128 + i];
    u32x2 guw[2][4];
#pragma unroll
    for (int ct = 0; ct < 2; ++ct)
#pragma unroll
        for (int g4 = 0; g4 < 4; ++g4) guw[ct][g4] = __builtin_nontemporal_load((const u32x2*)(GU + (size_t)(t0 + i) * 512 + g * 128 + ch * 64 + ct * 32 + 8 * g4 + 4 * hi));
    if (tid < 128) rv[tid] = __builtin_amdgcn_rsqf(((pss[0] + pss[1]) + (pss[2] + pss[3])) * (1.f / 128.f) + EPS);
    __syncthreads();
    f32x16 acc[2];
#pragma unroll
    for (int r = 0; r < 16; ++r) { acc[0][r] = 0.f; acc[1][r] = 0.f; }
#pragma unroll
    for (int ks = 0; ks < 8; ++ks) {
        const int j0 = 16 * ks + 8 * hi;
        f32x4 w0 = wv[ks][0], w1 = wv[ks][1];
#pragma unroll
        for (int e = 0; e < 4; ++e) { w0[e] *= rv[j0 + e]; w1[e] *= rv[j0 + 4 + e]; }
        const bf16x8 bf = __builtin_bit_cast(bf16x8, pack8(w0, w1));
        acc[0] = __builtin_amdgcn_mfma_f32_32x32x16_bf16(af[0][ks], bf, acc[0], 0, 0, 0);
        acc[1] = __builtin_amdgcn_mfma_f32_32x32x16_bf16(af[1][ks], bf, acc[1], 0, 0, 0);
    }
    float ssq = 0.f;
#pragma unroll
    for (int ct = 0; ct < 2; ++ct)
#pragma unroll
        for (int g4 = 0; g4 < 4; ++g4) {
            const int cb = g * 128 + ch * 64 + ct * 32 + 8 * g4 + 4 * hi;
            const f32x4 vgv = *(const f32x4*)(vg + cb), ogv = *(const f32x4*)(og + cb);
            const u32x2 gq = guw[ct][g4];
            const float o0 = BFLO(gq.x) * (acc[ct][4 * g4 + 0] * vgv[0] + bs), o1 = BFHI(gq.x) * (acc[ct][4 * g4 + 1] * vgv[1] + bs);
            const float o2 = BFLO(gq.y) * (acc[ct][4 * g4 + 2] * vgv[2] + bs), o3 = BFHI(gq.y) * (acc[ct][4 * g4 + 3] * vgv[3] + bs);
            ssq += (o0 * o0 + o1 * o1) + (o2 * o2 + o3 * o3);
            u32x2 w; w.x = cvt_pk_bf16(o0 * ogv[0], o1 * ogv[1]); w.y = cvt_pk_bf16(o2 * ogv[2], o3 * ogv[3]);
            *(u32x2*)(MIX + (size_t)(t0 + i) * D + 512 + cb) = w;
        }
    ssq += __shfl_xor(ssq, 32);
    if (hi == 0) SSQG[(size_t)(t0 + i) * 8 + g * 2 + ch] = ssq;
    __syncthreads();
}


#define XB_TMO      128
#define XB_XCNT(j)  (256  + 64 * (j))
#define XB_XSUB(j)  (1280 + 64 * (j))
#define XB_XGEN(j)  (2304 + 64 * (j))
#define XB_TOP      3328
#define XB_TOPGEN   3392
#define XCD_BAR_WORDS 3456
#define XB_SPIN_CAP (1u << 18)

__device__ __forceinline__ unsigned xb_ld(unsigned* p)              { return __hip_atomic_load(p, __ATOMIC_RELAXED, __HIP_MEMORY_SCOPE_AGENT); }
__device__ __forceinline__ unsigned xb_add(unsigned* p, unsigned v) { return __hip_atomic_fetch_add(p, v, __ATOMIC_RELAXED, __HIP_MEMORY_SCOPE_AGENT); }
__device__ __forceinline__ unsigned xb_xcc_id() { return (unsigned)__builtin_amdgcn_s_getreg((3 << 11) | 20) & 0xFu; }
#define XB_SPIN(cond, bar) do { unsigned _sp = 0; while (cond) { __builtin_amdgcn_s_sleep(1); \
    if ((++_sp & 255u) == 0u) { if (xb_ld(&(bar)[XB_TMO])) break; if (_sp > XB_SPIN_CAP) { atomicAdd(&(bar)[XB_TMO], 1u); break; } } } } while (0)

struct XcdBarrier {
    unsigned* bar; unsigned x;
    volatile LAS unsigned* st;
};

__device__ __forceinline__ XcdBarrier xcd_barrier_post(unsigned* bar, volatile LAS unsigned* st) {
    XcdBarrier b; b.bar = bar; b.x = xb_xcc_id(); b.st = st;
    if (threadIdx.x == 0) (void)xb_add(&bar[XB_XCNT(b.x)], 1u);
    return b;
}
__device__ __forceinline__ void xcd_barrier_complete(unsigned* bar, unsigned x, unsigned& nloc, unsigned& nx) {
    const unsigned G = gridDim.x * gridDim.y * gridDim.z;
    unsigned sum, cnt, mine, sp = 0u;
    for (;;) {
        sum = 0u; cnt = 0u; mine = 0u;
#pragma unroll
        for (unsigned j = 0; j < 16; ++j) { const unsigned c = xb_ld(&bar[XB_XCNT(j)]); sum += c; cnt += (c > 0u) ? 1u : 0u; mine = (j == x) ? c : mine; }
        if (sum == G) break;
        __builtin_amdgcn_s_sleep(1);
        if ((++sp & 255u) == 0u) { if (xb_ld(&bar[XB_TMO])) break; if (sp > XB_SPIN_CAP) { atomicAdd(&bar[XB_TMO], 1u); break; } }
    }
    nloc = mine > 0u ? mine : 1u; nx = cnt > 0u ? cnt : 1u;
}

__device__ __forceinline__ void xcd_barrier(const XcdBarrier& b) {
    asm volatile("s_waitcnt vmcnt(0)" ::: "memory");
    __syncthreads();
    if (threadIdx.x == 0) {
        unsigned* bar = b.bar;
        __builtin_amdgcn_s_waitcnt(0);
        unsigned nloc = b.st[0], nx = b.st[1];
        if (nloc == 0u) { xcd_barrier_complete(bar, b.x, nloc, nx); b.st[0] = nloc; b.st[1] = nx; }
        const unsigned old = xb_add(&bar[XB_XSUB(b.x)], 1u);
        const unsigned gen = old / nloc;
        if (old + 1u == (gen + 1u) * nloc) {
            __builtin_amdgcn_fence(__ATOMIC_RELEASE, "agent");
            asm volatile("s_waitcnt vmcnt(0)" ::: "memory");
            const unsigned og = xb_add(&bar[XB_TOP], 1u);
            const unsigned tg = og / nx;
            if (og + 1u == (tg + 1u) * nx) xb_add(&bar[XB_TOPGEN], 1u);
            else XB_SPIN(xb_ld(&bar[XB_TOPGEN]) == tg, bar);
            __builtin_amdgcn_fence(__ATOMIC_ACQUIRE, "agent");
            xb_add(&bar[XB_XGEN(b.x)], 1u);
            asm volatile("s_waitcnt vmcnt(0)" ::: "memory");
        } else {
            XB_SPIN(xb_ld(&bar[XB_XGEN(b.x)]) == gen, bar);
            __builtin_amdgcn_fence(__ATOMIC_ACQUIRE, "agent");
            asm volatile("s_waitcnt vmcnt(0)" ::: "memory");
        }
    }
    __syncthreads();
}

__device__ __forceinline__ float sum8(const float* p) { const f32x4 a = __builtin_nontemporal_load((const f32x4*)p), b = __builtin_nontemporal_load((const f32x4*)(p + 4)); return ((a[0] + a[1]) + (a[2] + a[3])) + ((b[0] + b[1]) + (b[2] + b[3])); }
__device__ __forceinline__ f32x4 ld_bf4(const bf16_t* p) { const u32x2 w = __builtin_nontemporal_load((const u32x2*)p); return (f32x4){BFLO(w.x), BFHI(w.x), BFLO(w.y), BFHI(w.y)}; }
__device__ __forceinline__ void rows_x1_h2(const float* xp, const float* xs_off, bf16_t* X1, const bf16_t* PA, const bf16_t* PG, const float* SSQA, const float* SSQG, const float* mods, const float* g2, bf16_t* H, int gw, int ngw, int lane) {
    for (int row0 = gw; row0 < NTOK; row0 += 2 * ngw) {
        f32x4 x[2][4], pa[2][4], pg[2][4]; float ra[2], rg[2];
#pragma unroll
        for (int p = 0; p < 2; ++p) { const int row = row0 + p * ngw; if (row < NTOK) {
            const float* xr = (row < NCTX ? xp : xs_off) + (size_t)row * D;
#pragma unroll
            for (int j = 0; j < 4; ++j) { const int col = 4 * lane + 256 * j; x[p][j] = __builtin_nontemporal_load((const f32x4*)(xr + col)); pa[p][j] = ld_bf4(PA + (size_t)row * D + col); pg[p][j] = ld_bf4(PG + (size_t)row * D + col); }
            ra[p] = sum8(SSQA + (size_t)row * 8); rg[p] = sum8(SSQG + (size_t)row * 8); } }
#pragma unroll
        for (int p = 0; p < 2; ++p) { const int row = row0 + p * ngw; if (row < NTOK) {
            const float* mp = mods + (size_t)mod_of_row(row) * 6144;
            const float fa = 1.0f / sqrtf(ra[p] * (1.f / 512.f) + EPS), fg = 1.0f / sqrtf(rg[p] * (1.f / 512.f) + EPS);
            float s = 0.f;
#pragma unroll
            for (int j = 0; j < 4; ++j) { const int col = 4 * lane + 256 * j; const f32x4 gt = *(const f32x4*)(mp + 2048 + col);
                x[p][j] = x[p][j] + gt * (pa[p][j] * fa + pg[p][j] * fg); s += dot4(x[p][j]); }
            const float rstd = 1.0f / sqrtf(wave_sum(s) * (1.f / D) + EPS);
#pragma unroll
            for (int j = 0; j < 4; ++j) { const int col = 4 * lane + 256 * j;
                { u32x2 wx; wx.x = cvt_pk_bf16(x[p][j][0], x[p][j][1]); wx.y = cvt_pk_bf16(x[p][j][2], x[p][j][3]); *(u32x2*)(X1 + (size_t)row * D + col) = wx; }
                const f32x4 gg = *(const f32x4*)(g2 + col), sh = *(const f32x4*)(mp + 3072 + col), sc = *(const f32x4*)(mp + 4096 + col);
                const f32x4 o = x[p][j] * rstd * gg * (sc + 1.f) + sh;
                u32x2 w; w.x = cvt_pk_bf16(o[0], o[1]); w.y = cvt_pk_bf16(o[2], o[3]);
                *(u32x2*)(H + (size_t)row * D + col) = w; } } }
    }
}
__device__ __forceinline__ void rows_final(const bf16_t* X1, const bf16_t* P0, const bf16_t* P1, const float* mods, const float* gf, float* out, int gw, int ngw, int lane) {
    for (int row0 = gw; row0 < NTOK; row0 += 2 * ngw) {
        f32x4 x[2][4], pa[2][4], pb[2][4];
#pragma unroll
        for (int p = 0; p < 2; ++p) { const int row = row0 + p * ngw; if (row < NTOK) {
#pragma unroll
            for (int j = 0; j < 4; ++j) { const size_t o = (size_t)row * D + 4 * lane + 256 * j; x[p][j] = ld_bf4(X1 + o); pa[p][j] = ld_bf4(P0 + o); pb[p][j] = ld_bf4(P1 + o); } } }
#pragma unroll
        for (int p = 0; p < 2; ++p) { const int row = row0 + p * ngw; if (row < NTOK) {
            const float* mp = mods + (size_t)mod_of_row(row) * 6144;
            float s = 0.f;
#pragma unroll
            for (int j = 0; j < 4; ++j) { const int col = 4 * lane + 256 * j; x[p][j] = x[p][j] + *(const f32x4*)(mp + 5120 + col) * (pa[p][j] + pb[p][j]); s += dot4(x[p][j]); }
            const float rstd = 1.0f / sqrtf(wave_sum(s) * (1.f / D) + EPS);
#pragma unroll
            for (int j = 0; j < 4; ++j) { const int col = 4 * lane + 256 * j; __builtin_nontemporal_store(x[p][j] * rstd * *(const f32x4*)(gf + col), (f32x4*)(out + (size_t)row * D + col)); } } }
    }
}

__device__ __forceinline__ void seam(int k, int lo, int hi_, const XcdBarrier& bar) { if (lo <= k && k + 1 < hi_) xcd_barrier(bar); }
__global__ void __launch_bounds__(512, 2) mk_fwd(Args a) {
    extern __shared__ __attribute__((aligned(16))) unsigned char lds_raw[];
    LAS unsigned char* lds = (LAS unsigned char*)lds_raw;
    cg::grid_group grid = cg::this_grid();
    const int tid = threadIdx.x, lane = tid & 63, wave = __builtin_amdgcn_readfirstlane(tid >> 6);
    const int G = gridDim.x, bx = blockIdx.x;
    const int vcu = (G % 8 == 0) ? (bx % 8) * (G / 8) + bx / 8 : bx;
    const int gw = bx * 8 + wave, ngw = G * 8;
    const int lo = a.ph_lo, hi_ = a.ph_hi;
    unsigned char* ws = a.ws;
    const float* xp = a.in[0]; const float* xs = a.in[1];
    volatile LAS unsigned* MISC = (volatile LAS unsigned*)(lds + 131072 + 320);
    if (tid < 32) MISC[tid] = 0u;
    __syncthreads();
    XcdBarrier bar = xcd_barrier_post((unsigned*)(ws + WS_CTL), MISC + 8);
#define WSP(T, off) ((T*)(ws + (off)))
    float* out_y = a.out; float* out_ckv = a.out + (size_t)NTOK * D; float* out_krope = out_ckv + (size_t)NCTX * 256;
#ifndef MK_SKIP
#define MK_SKIP 0
#endif
#define IN(k) (!((MK_SKIP >> (k)) & 1) && lo <= (k) && (k) < hi_)
#define PH(k) for (int d_ = 0; d_ < (IN(k) ? DUPP##k : 0); ++d_, seam(k, lo, hi_, bar))
#define SEAM(k) do { } while (0)
    if (lo < 0) grid.sync();

    PH(0) {
        bf16_t* WT1 = WSP(bf16_t, WS_WT1);
        const bool gv = bx < 192;
        f32x4 w4[16];
        if (gv) { const float* wb = a.in[6] + (size_t)(128 * wave) * 6144 + 32 * bx; const int lo_ = (lane >> 3) * 6144 + 4 * (lane & 7);
#pragma unroll
            for (int i = 0; i < 16; ++i) w4[i] = __builtin_nontemporal_load((const f32x4*)(wb + (size_t)(8 * i) * 6144 + lo_)); }
        LAS float* scond = (LAS float*)lds;
        LAS float* red = (LAS float*)(lds + 24576);
        if (gv) { float cv[10];
#pragma unroll
            for (int q = 0; q < 10; ++q) { const int idx = tid + 512 * q, c = idx >> 10, k = idx & 1023; cv[q] = (c == 0) ? a.in[5][k] : a.in[4][(c - 1) * 1024 + k]; }
#pragma unroll
            for (int q = 0; q < 10; ++q) scond[tid + 512 * q] = cv[q] * __builtin_amdgcn_rcpf(1.f + __expf(-cv[q])); }
        if (!gv) transpose_items(a, ws, (LAS float*)(lds + 32768 + wave * 8448), 0, TSPLIT, (bx - 192) * 8 + wave, (G - 192) * 8, lane);
        const int gt = bx * 512 + tid, ngt = G * 512;
        for (int idx = gt; idx < (INP - INW) * 1024 / 8; idx += ngt) *(u32x4*)(WT1 + (size_t)INW * 1024 + (size_t)idx * 8) = (u32x4){0u, 0u, 0u, 0u};
        for (int idx = gt; idx < 2048 * 256 / 4; idx += ngt) { const f32x4 v = __builtin_nontemporal_load((const f32x4*)(a.in[2] + (size_t)idx * 4)); u32x2 w; w.x = cvt_pk_bf16(v[0], v[1]); w.y = cvt_pk_bf16(v[2], v[3]);
            *(u32x2*)(WSP(bf16_t, WS_KVA) + (size_t)NTOK * 256 + (size_t)idx * 4) = w; }
        for (int idx = gt; idx < 2048 * 32 / 4; idx += ngt) { const f32x4 v = __builtin_nontemporal_load((const f32x4*)(a.in[3] + (size_t)idx * 4)); const int j = idx >> 3, c4 = idx & 7; u32x2 w; w.x = cvt_pk_bf16(v[0], v[1]); w.y = cvt_pk_bf16(v[2], v[3]);
            *(u32x2*)(WSP(bf16_t, WS_KR) + (size_t)(NCTX + 1536 * (j >> 9) + (j & 511)) * 32 + c4 * 4) = w; }
        if (gv) {
            __syncthreads();
            f32x4 acc5[5];
#pragma unroll
            for (int c = 0; c < 5; ++c) acc5[c] = (f32x4){0.f, 0.f, 0.f, 0.f};
#pragma unroll
            for (int i = 0; i < 16; ++i) { const int k = 128 * wave + 8 * i + (lane >> 3);
#pragma unroll
                for (int c = 0; c < 5; ++c) acc5[c] += w4[i] * scond[c * 1024 + k]; }
#pragma unroll
            for (int c = 0; c < 5; ++c)
#pragma unroll
                for (int e = 0; e < 4; ++e) { float v = acc5[c][e]; v += __shfl_xor(v, 8); v += __shfl_xor(v, 16); v += __shfl_xor(v, 32); if (lane < 8) red[(wave * 5 + c) * 32 + 4 * lane + e] = v; }
            __syncthreads();
            if (tid < 160) { const int c = tid >> 5, col = tid & 31; float sm = 0.f;
#pragma unroll
                for (int w = 0; w < 8; ++w) sm += red[(w * 5 + c) * 32 + col];
                WSP(float, WS_MODS)[c * 6144 + 32 * bx + col] = sm + a.in[7][32 * bx + col]; }
            __syncthreads();
        }
    }
    SEAM(0);
    PH(1) norm_rows(xp, xs - (size_t)NCTX * D, a.in[8], WSP(float, WS_MODS), 0, 1024, WSP(bf16_t, WS_H), gw, ngw, lane);
    SEAM(1);
    PH(2) {
        pg8::Gemm g{WSP(bf16_t, WS_H), WSP(bf16_t, WS_WT1), NTOK, INP, D, D, D}; pg8::StaticOrder S; S.init(NTOK, INP, G, bx);
        Epi1 E{WSP(bf16_t, WS_QLAT), WSP(bf16_t, WS_KVA), WSP(float, WS_KVRAW), WSP(bf16_t, WS_GVT), WSP(bf16_t, WS_GU), WSP(bf16_t, WS_KR), WSP(float, WS_SSQ1), out_krope, a.in[10], a.in[12], WSP(float, WS_ROPE)};
        pg8::gemm_phase<Epi1, pg8::StaticOrder, true, true>(lds, g, S, E);
        if (bx >= 224) transpose_items(a, ws, (LAS float*)(lds + wave * 8448), TSPLIT, TI1 + TI2 + TI3 + TI4 + TI5, (bx - 224) * 8 + wave, (G - 224) * 8, lane);
    }
    SEAM(2);
    PH(3) {
        if (bx < 96) { pg8::Gemm g{WSP(bf16_t, WS_QLAT), WSP(bf16_t, WS_WTQ), NTOK, 768, 384, 384, 384}; pg8::StaticOrder S; S.init(NTOK, 768, 96, bx); Epi2 E{WSP(bf16_t, WS_Q), WSP(float, WS_SSQ1), WSP(float, WS_ROPE)};
            pg8::gemm_phase<Epi2, pg8::StaticOrder, true, true>(lds, g, S, E); }
        else if (bx < 256) { pg8::Gemm g{WSP(bf16_t, WS_KVA), WSP(bf16_t, WS_WTKV), NKEY, 1024, 256, 256, 256}; pg8::StaticOrder S; S.init(NKEY, 1024, 160, bx - 96); Epi3 E{WSP(bf16_t, WS_KN), WSP(bf16_t, WS_VT), WSP(float, WS_SSQ1)};
            pg8::gemm_phase<Epi3, pg8::StaticOrder, true, true>(lds, g, S, E); }
    }
    SEAM(3);
    PH(4) {
        bf16_t* MIX = WSP(bf16_t, WS_MIX);
        for (int dup = 0; dup < DUP_ATT; ++dup)
        for (int u = vcu; u < 512; u += G) {
            if (u < 256) { const int seq = u >> 6, head = (u >> 3) & 7, qb = u & 7; attn_unit(lds, WSP(bf16_t, WS_Q), WSP(bf16_t, WS_KN), WSP(bf16_t, WS_KR), WSP(bf16_t, WS_VT), MIX, a.in[17], WSP(float, WS_SSQA), NCTX + seq * 1024 + qb * 128, head, NCTX + 1536 * seq, 1536); }
            else { const int v = u - 256, seq = v >> 4, head = (v >> 1) & 7, qb = v & 1; attn_unit(lds, WSP(bf16_t, WS_Q), WSP(bf16_t, WS_KN), WSP(bf16_t, WS_KR), WSP(bf16_t, WS_VT), MIX, a.in[17], WSP(float, WS_SSQA), seq * 256 + qb * 128, head, seq * 256, 256); }
        }
        for (int dup = 0; dup < DUP_SPA; ++dup)
        for (int u = vcu; u < 256; u += G) spatial_unit(lds, u >> 2, u & 3, WSP(bf16_t, WS_GVT), WSP(bf16_t, WS_GU), WSP(float, WS_SSQ1), a.in[15], a.in[16], a.in[14], a.in[18], MIX, WSP(float, WS_SSQG));
    }
    SEAM(4);
    PH(5) {
        pg8::Gemm g{WSP(bf16_t, WS_MIX), WSP(bf16_t, WS_WTO), NTOK, D, 512, D, D}; SplitOrder S; S.init(NTOK, D, 512, G, bx);
        EpiF32 E{WSP(bf16_t, WS_PA), WSP(bf16_t, WS_PG)};
        pg8::gemm_phase<EpiF32, SplitOrder, true, true>(lds, g, S, E);
    }
    SEAM(5);
    PH(6) rows_x1_h2(xp, xs - (size_t)NCTX * D, WSP(bf16_t, WS_X1), WSP(bf16_t, WS_PA), WSP(bf16_t, WS_PG), WSP(float, WS_SSQA), WSP(float, WS_SSQG), WSP(float, WS_MODS), a.in[20], WSP(bf16_t, WS_H), gw, ngw, lane);
    SEAM(6);
    PH(7) {
        pg8::Gemm g{WSP(bf16_t, WS_H), WSP(bf16_t, WS_WTUP), NTOK, DFF2, D, D, D}; pg8::StaticOrder S; S.init(NTOK, DFF2, G, bx);
        EpiConv E{WSP(bf16_t, WS_G), WSP(float, WS_SB), a.in[22], a.in[23]};
        pg8::gemm_phase<EpiConv, pg8::StaticOrder, true, true>(lds, g, S, E);
        if (bx >= 192) transpose_items(a, ws, (LAS float*)(lds + wave * 8448), TI1 + TI2 + TI3 + TI4 + TI5, TNIT, (bx - 192) * 8 + wave, (G - 192) * 8, lane);
    }
    SEAM(7);
    PH(8) {
        const float* cw = a.in[22]; const float* cbias = a.in[23]; const float* SB = WSP(float, WS_SB); bf16_t* Gb = WSP(bf16_t, WS_G);
        for (int task = bx * 512 + tid; task < 127 * 704; task += G * 512) {
            const int sl = task / 704, q = task % 704, ch = q * 4, r1 = 64 * (sl + 1);
            const int slen = (r1 < NCTX) ? 256 : 1024;
            if ((r1 & (slen - 1)) == 0) continue;
            f32x4 av[2][4];
#pragma unroll
            for (int bj = 0; bj < 2; ++bj) {
                av[bj][0] = __builtin_nontemporal_load((const f32x4*)(SB + ((size_t)(sl * 4 + 2) * 2 + bj) * DFF + ch)); av[bj][1] = __builtin_nontemporal_load((const f32x4*)(SB + ((size_t)(sl * 4 + 3) * 2 + bj) * DFF + ch));
                av[bj][2] = __builtin_nontemporal_load((const f32x4*)(SB + ((size_t)((sl + 1) * 4 + 0) * 2 + bj) * DFF + ch)); av[bj][3] = __builtin_nontemporal_load((const f32x4*)(SB + ((size_t)((sl + 1) * 4 + 1) * 2 + bj) * DFF + ch));
            }
            f32x4 o[2][2];
#pragma unroll
            for (int bj = 0; bj < 2; ++bj) { const float* wp = cw + bj * DFF + ch; const f32x4 w0 = *(const f32x4*)wp, w1 = *(const f32x4*)(wp + DFF2), w2 = *(const f32x4*)(wp + 2 * DFF2), bb = *(const f32x4*)(cbias + bj * DFF + ch);
                o[bj][0] = bb + w0 * av[bj][0] + w1 * av[bj][1] + w2 * av[bj][2]; o[bj][1] = bb + w0 * av[bj][1] + w1 * av[bj][2] + w2 * av[bj][3]; }
#pragma unroll
            for (int rr = 0; rr < 2; ++rr) { const f32x4 gt = o[0][rr], vl = o[1][rr]; u32x2 w;
                w.x = cvt_pk_bf16(gt[0] / (1.f + __expf(-gt[0])) * vl[0], gt[1] / (1.f + __expf(-gt[1])) * vl[1]);
                w.y = cvt_pk_bf16(gt[2] / (1.f + __expf(-gt[2])) * vl[2], gt[3] / (1.f + __expf(-gt[3])) * vl[3]);
                *(u32x2*)(Gb + (size_t)(r1 - 1 + rr) * DFF + ch) = w; }
        }
    }
    SEAM(8);
    PH(9) {
        pg8::Gemm g{WSP(bf16_t, WS_G), WSP(bf16_t, WS_WTDN), NTOK, D, DFF / 2, DFF, DFF}; SplitOrder S; S.init(NTOK, D, DFF / 2, G, bx);
        EpiF32 E{WSP(bf16_t, WS_P0), WSP(bf16_t, WS_P1)};
        pg8::gemm_phase<EpiF32, SplitOrder, true, true>(lds, g, S, E);
    }
    SEAM(9);
    PH(10) {
        const int col = 4 * lane, row0 = gw, row1 = gw + ngw;
        const f32x4 gg = *(const f32x4*)(a.in[12] + col);
        const float s0 = sum8(WSP(float, WS_SSQ1) + (size_t)row0 * SSQS + 12), s1 = sum8(WSP(float, WS_SSQ1) + (size_t)row1 * SSQS + 12);
        const f32x4 r0v = __builtin_nontemporal_load((const f32x4*)(WSP(float, WS_KVRAW) + (size_t)row0 * 256 + col)), r1v = __builtin_nontemporal_load((const f32x4*)(WSP(float, WS_KVRAW) + (size_t)row1 * 256 + col));
        rows_final(WSP(bf16_t, WS_X1), WSP(bf16_t, WS_P0), WSP(bf16_t, WS_P1), WSP(float, WS_MODS), a.in[25], out_y, gw, ngw, lane);
        __builtin_nontemporal_store(r0v * (1.0f / sqrtf(s0 * (1.f / 256.f) + EPS)) * gg, (f32x4*)(out_ckv + (size_t)row0 * 256 + col));
        __builtin_nontemporal_store(r1v * (1.0f / sqrtf(s1 * (1.f / 256.f) + EPS)) * gg, (f32x4*)(out_ckv + (size_t)row1 * 256 + col));
    }
#undef IN
#undef SEAM
}

extern "C" void kernel_launch(void* const* d_in, const int* in_sizes, int n_in, void* d_out, int out_size, void* d_ws, size_t ws_size, hipStream_t stream) {
    static int grid = 0;
    if (grid == 0) {
        if (n_in != 26 || ws_size < WS_END) { fprintf(stderr, "kernel_launch: unexpected n_in %d / ws %zu\n", n_in, ws_size); grid = -1; return; }
        int dev = 0, cus = 0, per_cu = 0;
        (void)hipGetDevice(&dev); (void)hipDeviceGetAttribute(&cus, hipDeviceAttributeMultiprocessorCount, dev);
        if (hipFuncSetAttribute((const void*)mk_fwd, hipFuncAttributeMaxDynamicSharedMemorySize, LDS_BYTES) != hipSuccess) { fprintf(stderr, "kernel_launch: hipFuncSetAttribute failed\n"); grid = -1; return; }
        if (hipOccupancyMaxActiveBlocksPerMultiprocessor(&per_cu, (const void*)mk_fwd, 512, LDS_BYTES) != hipSuccess || per_cu < 1) { fprintf(stderr, "kernel_launch: occupancy query says %d\n", per_cu); per_cu = 1; }
        (void)hipGetLastError();
        grid = cus * 1;
        if (grid != 256) { fprintf(stderr, "kernel_launch: this kernel is laid out for 256 CUs, found %d\n", grid); grid = -1; return; }
    }
    if (grid < 0) return;
    (void)hipMemsetAsync((char*)d_ws + WS_CTL, 0, CTL_BYTES, stream);
    Args a{};
    for (int i = 0; i < 26; ++i) a.in[i] = (const float*)d_in[i];
    a.out = (float*)d_out; a.ws = (unsigned char*)d_ws;
#if MK_ONE_LAUNCH
    a.ph_lo = 0; a.ph_hi = NPH;
    void* args[] = {&a};
    hipError_t e = hipLaunchCooperativeKernel((const void*)mk_fwd, dim3(grid), dim3(512), args, LDS_BYTES, stream);
    if (e != hipSuccess) fprintf(stderr, "cooperative launch failed: %s (grid %d)\n", hipGetErrorString(e), grid);
#else
    for (int p = 0; p < NPH; ++p) { a.ph_lo = p; a.ph_hi = p + 1; for (int r = 0; r < 1 + ((MK_REP >> p) & 1) * MK_REPN; ++r) hipLaunchKernelGGL(mk_fwd, dim3(grid), dim3(512), LDS_BYTES, stream, a); }
#endif
}
```
